# Optimizing an MI355X kernel written in HIP

```python
import jax, jax.numpy as jnp
from jax import lax
import numpy as np

D_MODEL = 1024
BATCH = 4
SEQ = 4096
DEPTH = 1

EXPAND = 2
D_MIX = EXPAND * D_MODEL
HEAD_DIM = 64
D_SSD = D_MIX // 2
D_SB = D_MIX - D_SSD
N_SSD_HEADS = D_SSD // HEAD_DIM
N_SB_HEADS = D_SB // HEAD_DIM
SSD_GROUPS = 2
SSD_STATE = 128
CONV_WIDTH = 4
D_CONV = D_SSD + 2 * SSD_GROUPS * SSD_STATE
SSD_CHUNK = 128
SB_BLOCK = 128
D_FF = -(-8 * D_MODEL // (3 * 256)) * 256
N_MOD = 6
EPS = 1e-6
IN_SPLITS = [int(s) for s in np.cumsum([D_SSD, D_CONV, N_SSD_HEADS, D_SB, D_SB])]
D_IN_PROJ = IN_SPLITS[-1] + D_SB

kernel_name = "hymba_ssd_stickbreaking_adaln_block"


def rms_norm(x, w):
    xf = x.astype(jnp.float32)
    y = xf * lax.rsqrt(jnp.mean(xf * xf, axis=-1, keepdims=True) + EPS)
    return (y * w.astype(jnp.float32)).astype(x.dtype)


def causal_depthwise_conv(u, w, b):
    out = lax.conv_general_dilated(
        u, w[:, None, :], window_strides=(1,), padding=[(CONV_WIDTH - 1, 0)],
        dimension_numbers=("NWC", "WIO", "NWC"), feature_group_count=u.shape[-1])
    return out + b


def ssd_chunked(x, dt, a, b_mat, c_mat):
    bsz, seq, n_heads, p = x.shape
    g, n = b_mat.shape[2], b_mat.shape[3]
    e = n_heads // g
    nc, t = seq // SSD_CHUNK, SSD_CHUNK
    xg = (x * dt[..., None]).reshape(bsz, nc, t, g, e, p)
    a_dt = jnp.moveaxis((a * dt).reshape(bsz, nc, t, g, e), 2, -1)
    a_cs = jnp.cumsum(a_dt, axis=-1)
    bm = b_mat.reshape(bsz, nc, t, g, n)
    cm = c_mat.reshape(bsz, nc, t, g, n)
    idx = jnp.arange(t)
    causal = idx[:, None] >= idx[None, :]
    seg = a_cs[..., :, None] - a_cs[..., None, :]
    decay = jnp.exp(jnp.where(causal, seg, -jnp.inf))
    scores = jnp.einsum("bclgn,bcsgn->bcgls", cm, bm)
    y_diag = jnp.einsum("bcgls,bcgels,bcsgep->bclgep", scores, decay, xg)
    decay_states = jnp.exp(a_cs[..., -1:] - a_cs)
    states = jnp.einsum("bclgn,bcgel,bclgep->bcgepn", bm, decay_states, xg)
    chunk_decay = jnp.exp(a_cs[..., -1])

    def step(carry, inp):
        st, dec = inp
        return carry * dec[..., None, None] + st, carry

    init = jnp.zeros_like(states[:, 0])
    _, prev_states = lax.scan(step, init, (jnp.moveaxis(states, 1, 0), jnp.moveaxis(chunk_decay, 1, 0)))
    prev_states = jnp.moveaxis(prev_states, 0, 1)
    y_off = jnp.einsum("bclgn,bcgepn,bcgel->bclgep", cm, prev_states, jnp.exp(a_cs))
    return (y_diag + y_off).reshape(bsz, seq, n_heads, p)


def ssd_mixer(z, xbc, dt_raw, conv_w, conv_b, dt_bias, a_log, d_skip, norm_w):
    bsz, seq, _ = z.shape
    f32 = jnp.float32
    xbc = jax.nn.silu(causal_depthwise_conv(xbc, conv_w, conv_b)).astype(f32)
    xs = xbc[..., :D_SSD]
    bm = xbc[..., D_SSD:D_SSD + SSD_GROUPS * SSD_STATE].reshape(bsz, seq, SSD_GROUPS, SSD_STATE)
    cm = xbc[..., D_SSD + SSD_GROUPS * SSD_STATE:].reshape(bsz, seq, SSD_GROUPS, SSD_STATE)
    xh = xs.reshape(bsz, seq, N_SSD_HEADS, HEAD_DIM)
    dt = jax.nn.softplus(dt_raw.astype(f32) + dt_bias.astype(f32))
    a = -jnp.exp(a_log.astype(f32))
    y = ssd_chunked(xh, dt, a, bm, cm) + d_skip.astype(f32)[:, None] * xh
    y = y.reshape(bsz, seq, D_SSD) * jax.nn.silu(z.astype(f32))
    yg = y.reshape(bsz, seq, SSD_GROUPS, D_SSD // SSD_GROUPS)
    yg = yg * lax.rsqrt(jnp.mean(yg * yg, axis=-1, keepdims=True) + EPS)
    return (yg.reshape(bsz, seq, D_SSD) * norm_w.astype(f32)).astype(z.dtype)


def stick_breaking_mixer(q, k, v, q_norm_w, k_norm_w):
    bsz, seq, _ = q.shape
    f32 = jnp.float32
    q = rms_norm(q.reshape(bsz, seq, N_SB_HEADS, HEAD_DIM), q_norm_w).astype(f32).transpose(0, 2, 1, 3)
    k = rms_norm(k.reshape(bsz, seq, N_SB_HEADS, HEAD_DIM), k_norm_w).astype(f32).transpose(0, 2, 1, 3)
    vh = v.reshape(bsz, seq, N_SB_HEADS, HEAD_DIM).astype(f32).transpose(0, 2, 1, 3)
    scale = HEAD_DIM ** -0.5
    outs = []
    for blk in range(seq // SB_BLOCK):
        start, end = blk * SB_BLOCK, (blk + 1) * SB_BLOCK
        qb, kp, vp = q[:, :, start:end], k[:, :, :end], vh[:, :, :end]
        logits = jnp.einsum("bhqd,bhkd->bhqk", qb, kp) * scale
        t_pos = start + jnp.arange(SB_BLOCK)
        s_pos = jnp.arange(end)
        strict = s_pos[None, :] < t_pos[:, None]
        log_rem = jnp.where(strict, jax.nn.log_sigmoid(-logits), 0.0)
        log_between = lax.cumsum(log_rem, axis=3, reverse=True) - log_rem
        weights = jnp.where(strict, jnp.exp(jax.nn.log_sigmoid(logits) + log_between), 0.0)
        outs.append(jnp.einsum("bhqk,bhkd->bhqd", weights, vp))
    o = jnp.concatenate(outs, axis=2)
    return o.transpose(0, 2, 1, 3).reshape(bsz, seq, D_SB).astype(v.dtype)


def setup_inputs(seed: int = 0) -> dict:
    key = jax.random.key(seed)
    ks = jax.random.split(key, 24)
    f32 = jnp.float32
    nrm = lambda k, shape, s: jax.random.normal(k, shape, f32) * s
    dt0 = jnp.exp(jax.random.uniform(ks[8], (DEPTH, N_SSD_HEADS), f32,
                                     float(np.log(1e-3)), float(np.log(1e-1))))
    dt_bias = dt0 + jnp.log(-jnp.expm1(-dt0))
    return {
        "x": nrm(ks[0], (BATCH, SEQ, D_MODEL), 1.0),
        "c": nrm(ks[1], (BATCH, D_MODEL), 1.0),
        "w_ada": nrm(ks[2], (DEPTH, D_MODEL, N_MOD * D_MODEL), 0.5 * D_MODEL ** -0.5),
        "b_ada": nrm(ks[3], (DEPTH, N_MOD * D_MODEL), 0.01),
        "norm1_w": 1.0 + nrm(ks[4], (DEPTH, D_MODEL), 0.02),
        "w_in": nrm(ks[5], (DEPTH, D_MODEL, D_IN_PROJ), D_MODEL ** -0.5),
        "conv_w": nrm(ks[6], (DEPTH, CONV_WIDTH, D_CONV), CONV_WIDTH ** -0.5),
        "conv_b": nrm(ks[7], (DEPTH, D_CONV), 0.01),
        "dt_bias": dt_bias,
        "a_log": jnp.log(jax.random.uniform(ks[9], (DEPTH, N_SSD_HEADS), f32, 1.0, 16.0)),
        "d_skip": 1.0 + nrm(ks[10], (DEPTH, N_SSD_HEADS), 0.02),
        "ssd_norm_w": 1.0 + nrm(ks[11], (DEPTH, D_SSD), 0.02),
        "q_norm_w": 1.0 + nrm(ks[12], (DEPTH, HEAD_DIM), 0.02),
        "k_norm_w": 1.0 + nrm(ks[13], (DEPTH, HEAD_DIM), 0.02),
        "w_out": nrm(ks[14], (DEPTH, D_MIX, D_MODEL), D_MIX ** -0.5),
        "norm2_w": 1.0 + nrm(ks[15], (DEPTH, D_MODEL), 0.02),
        "w_gate": nrm(ks[16], (DEPTH, D_MODEL, D_FF), D_MODEL ** -0.5),
        "w_up": nrm(ks[17], (DEPTH, D_MODEL, D_FF), D_MODEL ** -0.5),
        "w_down": nrm(ks[18], (DEPTH, D_FF, D_MODEL), D_FF ** -0.5),
    }


def reference(x, c, w_ada, b_ada, norm1_w, w_in, conv_w, conv_b, dt_bias, a_log, d_skip,
              ssd_norm_w, q_norm_w, k_norm_w, w_out, norm2_w, w_gate, w_up, w_down):
    cond = jax.nn.silu(c)
    for layer in range(DEPTH):
        mod = (cond @ w_ada[layer] + b_ada[layer])[:, None, :]
        sh1, sc1, g1, sh2, sc2, g2 = jnp.split(mod, N_MOD, axis=-1)
        h = rms_norm(x, norm1_w[layer]) * (1.0 + sc1) + sh1
        proj = h @ w_in[layer]
        z, xbc, dt_raw, q, k, v = jnp.split(proj, IN_SPLITS, axis=-1)
        y_ssd = ssd_mixer(z, xbc, dt_raw, conv_w[layer], conv_b[layer], dt_bias[layer],
                          a_log[layer], d_skip[layer], ssd_norm_w[layer])
        y_sb = stick_breaking_mixer(q, k, v, q_norm_w[layer], k_norm_w[layer])
        mix = jnp.concatenate([y_ssd, y_sb], axis=-1) @ w_out[layer]
        x = x + g1 * mix
        h = rms_norm(x, norm2_w[layer]) * (1.0 + sc2) + sh2
        ffn = (jax.nn.silu(h @ w_gate[layer]) * (h @ w_up[layer])) @ w_down[layer]
        x = x + g2 * ffn
    return x
```

```cpp
#include <hip/hip_runtime.h>
#include <hip/hip_cooperative_groups.h>
#include <cstdio>
#include <cstdint>
namespace cg = cooperative_groups;

#define LAS __attribute__((address_space(3)))
#define GAS __attribute__((address_space(1)))
typedef unsigned short bf16_t;
typedef short bf16x8 __attribute__((ext_vector_type(8)));
typedef float f32x4 __attribute__((ext_vector_type(4)));
typedef unsigned u32x4 __attribute__((ext_vector_type(4)));
typedef unsigned u32x2 __attribute__((ext_vector_type(2)));

__device__ __forceinline__ unsigned f2bf(float f) { unsigned u = __builtin_bit_cast(unsigned, f); return (u + 0x7fffu + ((u >> 16) & 1u)) >> 16; }
typedef __bf16 bf16x2_t __attribute__((ext_vector_type(2)));
typedef float f32x2_t __attribute__((ext_vector_type(2)));
__device__ __forceinline__ unsigned cvt_pk(float lo, float hi) { const f32x2_t v = {lo, hi}; const bf16x2_t b = __builtin_convertvector(v, bf16x2_t); return __builtin_bit_cast(unsigned, b); }
__device__ __forceinline__ float bflo(unsigned w) { return __builtin_bit_cast(float, w << 16); }
__device__ __forceinline__ float bfhi(unsigned w) { return __builtin_bit_cast(float, w & 0xffff0000u); }
__device__ __forceinline__ float bf2f(bf16_t b) { return __builtin_bit_cast(float, (unsigned)b << 16); }
__device__ __forceinline__ float wave_sum(float v) {
#pragma unroll
    for (int o = 1; o < 64; o <<= 1) v += __shfl_xor(v, o);
    return v;
}
#define MFMA16(a, b, c) __builtin_amdgcn_mfma_f32_16x16x32_bf16((a), (b), (c), 0, 0, 0)

namespace pg8 {
constexpr int BM = 256, BK = 64, HALF = 128, HTB = HALF * BK * 2, STAGE_BYTES = 8 * HTB, NXCD = 8, WGM = 8;
__host__ __device__ __forceinline__ int lds_byte(int r, int c) { const int st = (r >> 4) * 2 + (c >> 5), rr = r & 15, cc = c & 31, ob = rr * 64 + cc * 2; return st * 1024 + (ob ^ (((ob >> 9) & 1) << 5)); }
__host__ __device__ __forceinline__ void stage_rc(int b, int& R, int& C) { const int st = b / 1024, sb = b % 1024, swz = sb ^ (((sb >> 9) & 1) << 5); R = (st >> 1) * 16 + swz / 64; C = (st & 1) * 32 + (swz % 64) / 2; }
__host__ __device__ __forceinline__ int perm32(int rho) { const int n = rho >> 4, i = rho & 15; return 8 * (i >> 2) + 4 * n + (i & 3); }
struct Unit { int pm, pn; };
struct Gemm { const bf16_t* A; const bf16_t* Bt; int M, N, K, lda; };
struct StaticOrder {
    int nM, nN, nwg, G, c;
    __device__ void init(int M, int N, int G_, int c_) { nM = M / BM; nN = N / BM; nwg = nM * nN; G = G_; c = c_; }
    __device__ bool next(int i, Unit& u) const {
        const long L = (long)i * G + c; if (L >= nwg) return false;
        int wgid = (int)L; { const int q = nwg / NXCD, r = nwg % NXCD, xcd = wgid % NXCD, off = wgid / NXCD; wgid = (xcd < r ? xcd * (q + 1) : r * (q + 1) + (xcd - r) * q) + off; }
        const int nig = WGM * nN, gid = wgid / nig, fm = gid * WGM, gsz = (nM - fm) < WGM ? (nM - fm) : WGM;
        u.pm = fm + ((wgid % nig) % gsz); u.pn = (wgid % nig) / gsz; return true;
    }
};

template <class Epi, bool ALIGN_EPI>
__device__ __forceinline__ void gemm_phase(LAS unsigned char* lds, const Gemm g, const StaticOrder& S, const Epi& E) {
    const int tid = threadIdx.x, wid = __builtin_amdgcn_readfirstlane(tid >> 6), lane = tid & 63, wr = wid >> 2, wc = wid & 3, fr = lane & 15, fq = lane >> 4;
    const int K = g.K, nt = K / BK, lda = g.lda;
    unsigned voffA[2], voffB[2];
#pragma unroll
    for (int i = 0; i < 2; ++i) { int R, C; stage_rc(tid * 16 + i * 8192, R, C); const int Rb = Epi::PERM ? ((R & ~31) + perm32(R & 31)) : R;
        voffA[i] = (unsigned)(R * lda + C) * 2u; voffB[i] = (unsigned)(Rb * K + C) * 2u; }
    const size_t kstep = (size_t)(BK * 2);
    const size_t hstepA = (size_t)HALF * lda * 2, hstepB = (size_t)HALF * K * 2;
    const size_t tstepA = 2 * hstepA, tstepB = 2 * hstepB;
    const unsigned ldsw = (unsigned)wid * 1024u;
    const int aoff = lds_byte(wr * 64 + fr, fq * 8), boff = lds_byte(wc * 32 + fr, fq * 8);
#define PG8_SA(b, h) (((b) * 2 + (h)) * HTB)
#define PG8_SB(b, h) ((4 + (b) * 2 + (h)) * HTB)
#define PG8_STAGE(bufoff, gbase, voff) do { _Pragma("unroll") for (int _i = 0; _i < 2; ++_i) \
        __builtin_amdgcn_global_load_lds((const unsigned*)((const char*)(gbase) + (voff)[_i]), (LAS unsigned*)(lds + (bufoff) + ldsw + _i * 8192), 16, 0, 0); } while (0)
#define PG8_LDA(dst, b, h) do { _Pragma("unroll") for (int m = 0; m < 4; ++m) _Pragma("unroll") for (int k = 0; k < 2; ++k) dst[m][k] = *(const LAS bf16x8*)(lds + PG8_SA(b, h) + aoff + m * 2048 + k * 1024); } while (0)
#define PG8_LDB(dst, b, h) do { _Pragma("unroll") for (int n = 0; n < 2; ++n) _Pragma("unroll") for (int k = 0; k < 2; ++k) dst[n][k] = *(const LAS bf16x8*)(lds + PG8_SB(b, h) + boff + n * 2048 + k * 1024); } while (0)
#define PG8_MMA(ai, bj, At, Bt) do { __builtin_amdgcn_s_setprio(1); _Pragma("unroll") for (int m = 0; m < 4; ++m) _Pragma("unroll") for (int n = 0; n < 2; ++n) _Pragma("unroll") for (int k = 0; k < 2; ++k) \
        acc[ai][bj][m][n] = __builtin_amdgcn_mfma_f32_16x16x32_bf16(Bt[n][k], At[m][k], acc[ai][bj][m][n], 0, 0, 0); __builtin_amdgcn_s_setprio(0); } while (0)
#define PG8_WAIT_V(n) asm volatile("s_waitcnt vmcnt(" #n ")" ::: "memory")
#define PG8_WAIT_L(n) asm volatile("s_waitcnt lgkmcnt(" #n ")" ::: "memory")
#define PG8_BAR __builtin_amdgcn_s_barrier()
#define PG8_SCHED __builtin_amdgcn_sched_barrier(0)
    Unit cur, nxt; int ui = 0;
    if (!S.next(0, cur)) return;
    f32x4 acc[2][2][4][2];
#pragma unroll
    for (int a = 0; a < 2; ++a)
#pragma unroll
        for (int b = 0; b < 2; ++b)
#pragma unroll
            for (int m = 0; m < 4; ++m)
#pragma unroll
                for (int n = 0; n < 2; ++n) acc[a][b][m][n] = (f32x4){0.f, 0.f, 0.f, 0.f};
    bf16x8 At[4][2], B0[2][2], B1[2][2];
    const char* cA = (const char*)g.A + (size_t)cur.pm * tstepA; const char* cB = (const char*)g.Bt + (size_t)cur.pn * tstepB;
    PG8_STAGE(PG8_SB(0, 0), cB, voffB); PG8_STAGE(PG8_SB(0, 1), cB + hstepB, voffB); PG8_STAGE(PG8_SA(0, 0), cA, voffA); PG8_STAGE(PG8_SA(0, 1), cA + hstepA, voffA);
    if (wr == 1) PG8_BAR;
    PG8_WAIT_V(2); PG8_BAR;
    PG8_STAGE(PG8_SB(1, 0), cB + kstep, voffB); PG8_STAGE(PG8_SA(1, 0), cA + kstep, voffA); PG8_STAGE(PG8_SB(1, 1), cB + hstepB + kstep, voffB);
    PG8_WAIT_V(6); PG8_BAR;
    for (;;) {
        const bool has_next = S.next(ui + 1, nxt);
        const char* nA = has_next ? (const char*)g.A + (size_t)nxt.pm * tstepA : cA; const char* nB = has_next ? (const char*)g.Bt + (size_t)nxt.pn * tstepB : cB;
        for (int t = 0; t < nt; t += 2) {
            const bool last = (t == nt - 2);
            const char* a1 = cA + (size_t)(t + 1) * kstep;
            const char* a2 = last ? nA : cA + (size_t)(t + 2) * kstep; const char* b2 = last ? nB : cB + (size_t)(t + 2) * kstep;
            const char* a3 = a2 + kstep; const char* b3 = b2 + kstep;
            PG8_LDB(B0, 0, 0); PG8_LDB(B1, 0, 1); PG8_SCHED; PG8_LDA(At, 0, 0); PG8_STAGE(PG8_SA(1, 1), a1 + hstepA, voffA);
            PG8_WAIT_V(8); PG8_WAIT_L(0); PG8_BAR; PG8_MMA(0, 0, At, B0); PG8_MMA(0, 1, At, B1); PG8_BAR; PG8_SCHED;
            PG8_LDA(At, 0, 1); PG8_STAGE(PG8_SB(0, 0), b2, voffB); PG8_STAGE(PG8_SB(0, 1), b2 + hstepB, voffB); PG8_STAGE(PG8_SA(0, 0), a2, voffA);
            PG8_WAIT_V(8); PG8_WAIT_L(0); PG8_BAR; PG8_MMA(1, 0, At, B0); PG8_MMA(1, 1, At, B1); PG8_BAR; PG8_SCHED;
            PG8_LDB(B0, 1, 0); PG8_LDB(B1, 1, 1); PG8_SCHED; PG8_LDA(At, 1, 0); PG8_STAGE(PG8_SA(0, 1), a2 + hstepA, voffA);
            PG8_WAIT_V(8); PG8_WAIT_L(0); PG8_BAR; PG8_MMA(0, 0, At, B0); PG8_MMA(0, 1, At, B1); PG8_BAR; PG8_SCHED;
            PG8_LDA(At, 1, 1); PG8_STAGE(PG8_SB(1, 0), b3, voffB); PG8_STAGE(PG8_SB(1, 1), b3 + hstepB, voffB); PG8_STAGE(PG8_SA(1, 0), a3, voffA);
            PG8_WAIT_V(8); PG8_WAIT_L(0); PG8_BAR; PG8_MMA(1, 0, At, B0); PG8_MMA(1, 1, At, B1); PG8_BAR; PG8_SCHED;
        }
        if constexpr (ALIGN_EPI) { if (wr == 0) PG8_BAR; }
        E(acc, cur, wr, wc, fr, fq);
        if (!has_next) break;
#pragma unroll
        for (int a = 0; a < 2; ++a)
#pragma unroll
            for (int b = 0; b < 2; ++b)
#pragma unroll
                for (int m = 0; m < 4; ++m)
#pragma unroll
                    for (int n = 0; n < 2; ++n) acc[a][b][m][n] = (f32x4){0.f, 0.f, 0.f, 0.f};
        cur = nxt; cA = nA; cB = nB; ++ui;
        if constexpr (ALIGN_EPI) { if (wr == 1) PG8_BAR; }
    }
    PG8_WAIT_V(0);
    if constexpr (!ALIGN_EPI) { if (wr == 0) PG8_BAR; }
    PG8_BAR;
#undef PG8_SA
#undef PG8_SB
#undef PG8_STAGE
#undef PG8_LDA
#undef PG8_LDB
#undef PG8_MMA
#undef PG8_WAIT_V
#undef PG8_WAIT_L
#undef PG8_BAR
#undef PG8_SCHED
}
}

constexpr int NB = 4, SEQ = 4096, DM = 1024, MT = NB * SEQ, DIN = 5648, DFF = 2816;
constexpr size_t MiB = 1u << 20;
constexpr size_t WS_MODP = 0;
constexpr size_t WS_MOD = 1536 * 1024;
constexpr size_t WS_CDEC = WS_MOD + 98304;
constexpr size_t WS_BAR = 1792 * 1024;
constexpr size_t WS_WIN = 2 * MiB;
constexpr size_t WS_WOUT = 13 * MiB;
constexpr size_t WS_WGU = 17 * MiB;
constexpr size_t WS_WDN = 28 * MiB;
constexpr size_t WS_DT = 34 * MiB;
constexpr size_t WS_H = 35 * MiB;
constexpr size_t WS_PROJ = 67 * MiB;
constexpr size_t WS_VT = 163 * MiB;
constexpr size_t WS_XBC = 195 * MiB;
constexpr size_t WS_END = 243 * MiB;
constexpr size_t WS_ACT = WS_PROJ;
constexpr size_t WS_ST = WS_XBC;
constexpr int LDS_BYTES = 147456;

struct Params { const float* in[19]; float* out; unsigned char* ws; int ph_lo, ph_hi; };


#define XB_TMO      128
#define XB_XCNT(j)  (256  + 64 * (j))
#define XB_XSUB(j)  (1280 + 64 * (j))
#define XB_XGEN(j)  (2304 + 64 * (j))
#define XB_TOP      3328
#define XB_TOPGEN   3392
#define XCD_BAR_WORDS 3456
#define XB_SPIN_CAP (1u << 18)
__device__ __forceinline__ unsigned xb_ld(unsigned* p)              { return __hip_atomic_load(p, __ATOMIC_RELAXED, __HIP_MEMORY_SCOPE_AGENT); }
__device__ __forceinline__ unsigned xb_add(unsigned* p, unsigned v) { return __hip_atomic_fetch_add(p, v, __ATOMIC_RELAXED, __HIP_MEMORY_SCOPE_AGENT); }
__device__ __forceinline__ unsigned xb_xcc_id() { return (unsigned)__builtin_amdgcn_s_getreg((3 << 11) | 20) & 0xFu; }
#define XB_SPIN(cond, bar) do { unsigned _sp = 0; while (cond) { __builtin_amdgcn_s_sleep(1); \
    if ((++_sp & 255u) == 0u) { if (xb_ld(&(bar)[XB_TMO])) break; if (_sp > XB_SPIN_CAP) { atomicAdd(&(bar)[XB_TMO], 1u); break; } } } } while (0)
__device__ __forceinline__ void xcd_barrier_complete(unsigned* bar, unsigned x, unsigned& nloc, unsigned& nx) {
    const unsigned G = gridDim.x * gridDim.y * gridDim.z;
    unsigned sum, cnt, mine, sp = 0u;
    for (;;) {
        sum = 0u; cnt = 0u; mine = 0u;
#pragma unroll
        for (unsigned j = 0; j < 16; ++j) { const unsigned c = xb_ld(&bar[XB_XCNT(j)]); sum += c; cnt += (c > 0u) ? 1u : 0u; mine = (j == x) ? c : mine; }
        if (sum == G) break;
        __builtin_amdgcn_s_sleep(1);
        if ((++sp & 255u) == 0u) { if (xb_ld(&bar[XB_TMO])) break; if (sp > XB_SPIN_CAP) { atomicAdd(&bar[XB_TMO], 1u); break; } }
    }
    nloc = mine > 0u ? mine : 1u; nx = cnt > 0u ? cnt : 1u;
}
__device__ __forceinline__ void xcd_barrier(unsigned* bar, volatile LAS unsigned* st) {
    asm volatile("s_waitcnt vmcnt(0)" ::: "memory");
    __syncthreads();
    if (threadIdx.x == 0) {
        const unsigned x = xb_xcc_id();
        __builtin_amdgcn_s_waitcnt(0);
        unsigned nloc = st[0], nx = st[1];
        if (nloc == 0u) { xcd_barrier_complete(bar, x, nloc, nx); st[0] = nloc; st[1] = nx; }
        const unsigned old = xb_add(&bar[XB_XSUB(x)], 1u);
        const unsigned gen = old / nloc;
        if (old + 1u == (gen + 1u) * nloc) {
            __builtin_amdgcn_fence(__ATOMIC_RELEASE, "agent");
            asm volatile("s_waitcnt vmcnt(0)" ::: "memory");
            const unsigned og = xb_add(&bar[XB_TOP], 1u);
            const unsigned tg = og / nx;
            if (og + 1u == (tg + 1u) * nx) xb_add(&bar[XB_TOPGEN], 1u);
            else XB_SPIN(xb_ld(&bar[XB_TOPGEN]) == tg, bar);
            __builtin_amdgcn_fence(__ATOMIC_ACQUIRE, "agent");
            xb_add(&bar[XB_XGEN(x)], 1u);
            asm volatile("s_waitcnt vmcnt(0)" ::: "memory");
        } else {
            XB_SPIN(xb_ld(&bar[XB_XGEN(x)]) == gen, bar);
            __builtin_amdgcn_fence(__ATOMIC_ACQUIRE, "agent");
            asm volatile("s_waitcnt vmcnt(0)" ::: "memory");
        }
    }
    __syncthreads();
}

struct EpiProj {
    static constexpr bool PERM = true;
    GAS bf16_t* P; GAS bf16_t* X; const GAS float* qnw; const GAS float* knw; GAS bf16_t* KF;
    __device__ __forceinline__ void operator()(const f32x4 (&acc)[2][2][4][2], const pg8::Unit& u, int wr, int wc, int fr, int fq) const {
        const int row0 = u.pm * 256 + wr * 64 + fr;
        if (u.pn >= 4 && u.pn < 12) {
            const bool isq = u.pn < 8; const GAS float* nw = isq ? qnw : knw; const float sc = isq ? 0.125f * 1.44269504089f : 1.f;
            const int colb = (isq ? 1024 : 2048) + 64 * (4 * (u.pn & 3) + wc) + 8 * fq;
            f32x4 w4[2][2];
#pragma unroll
            for (int bj = 0; bj < 2; ++bj)
#pragma unroll
                for (int n = 0; n < 2; ++n) w4[bj][n] = *(const GAS f32x4*)(nw + 32 * bj + 8 * fq + 4 * n) * sc;
#pragma unroll
            for (int ai = 0; ai < 2; ++ai)
#pragma unroll
                for (int m = 0; m < 4; ++m) { float ss = 0.f;
#pragma unroll
                    for (int bj = 0; bj < 2; ++bj)
#pragma unroll
                        for (int n = 0; n < 2; ++n) { const f32x4 v = acc[ai][bj][m][n]; ss += (v[0] * v[0] + v[1] * v[1]) + (v[2] * v[2] + v[3] * v[3]); }
                    ss += __shfl_xor(ss, 16); ss += __shfl_xor(ss, 32);
                    const float rstd = 1.0f / sqrtf(ss * (1.f / 64.f) + 1e-6f);
                    const int row = row0 + ai * 128 + m * 16;
                    GAS bf16_t* rowp = P + (size_t)row * 3072 + colb;
                    GAS bf16_t* kfp = KF + ((((size_t)((row >> 12) * 16 + 4 * (u.pn & 3) + wc) * 256 + ((row & 4095) >> 4)) * 2) * 64 + fq * 16 + fr) * 8;
#pragma unroll
                    for (int bj = 0; bj < 2; ++bj) { const f32x4 v0 = acc[ai][bj][m][0] * rstd * w4[bj][0], v1 = acc[ai][bj][m][1] * rstd * w4[bj][1];
                        u32x4 w; w.x = cvt_pk(v0[0], v0[1]); w.y = cvt_pk(v0[2], v0[3]); w.z = cvt_pk(v1[0], v1[1]); w.w = cvt_pk(v1[2], v1[3]);
                        if (isq) *(GAS u32x4*)(rowp + bj * 32) = w; else *(GAS u32x4*)(kfp + bj * 512) = w; } }
            return;
        }
        GAS bf16_t* base; int ldc, colt;
        if (u.pn < 12) { base = P; ldc = 3072; colt = u.pn * 256; } else { base = X; ldc = 1536; colt = (u.pn - 12) * 256; }
        const int col0 = colt + wc * 32 + 8 * fq;
#pragma unroll
        for (int ai = 0; ai < 2; ++ai)
#pragma unroll
            for (int m = 0; m < 4; ++m) { GAS bf16_t* rowp = base + (size_t)(row0 + ai * 128 + m * 16) * ldc + col0;
#pragma unroll
                for (int bj = 0; bj < 2; ++bj) { const f32x4 v0 = acc[ai][bj][m][0], v1 = acc[ai][bj][m][1];
                    u32x4 w; w.x = cvt_pk(v0[0], v0[1]); w.y = cvt_pk(v0[2], v0[3]); w.z = cvt_pk(v1[0], v1[1]); w.w = cvt_pk(v1[2], v1[3]);
                    *(GAS u32x4*)(rowp + bj * 128) = w; } }
    }
};
struct EpiVT {
    static constexpr bool PERM = true;
    GAS bf16_t* VT;
    __device__ __forceinline__ void operator()(const f32x4 (&acc)[2][2][4][2], const pg8::Unit& u, int wr, int wc, int fr, int fq) const {
        const int b = u.pn >> 4, row0 = u.pm * 256 + wr * 64 + fr, qa = 2 * (fq & 1), hi = fq >> 1;
#pragma unroll
        for (int ai = 0; ai < 2; ++ai)
#pragma unroll
            for (int m = 0; m < 4; ++m) { const int c = row0 + ai * 128 + m * 16;
#pragma unroll
                for (int bj = 0; bj < 2; ++bj) { const f32x4 v0 = acc[ai][bj][m][0], v1 = acc[ai][bj][m][1];
                    const int tg = (u.pn & 15) * 8 + wc + bj * 4;
                    GAS bf16_t* vp = VT + (((((size_t)(b * 16 + (c >> 6)) * 128 + tg) * 4 + ((c >> 4) & 3)) * 64) + qa * 16 + fr) * 8 + 4 * hi;
                    u32x2 wa, wb; wa.x = cvt_pk(v0[0], v0[1]); wa.y = cvt_pk(v0[2], v0[3]); wb.x = cvt_pk(v1[0], v1[1]); wb.y = cvt_pk(v1[2], v1[3]);
                    *(GAS u32x2*)vp = wa; *(GAS u32x2*)(vp + 128) = wb; } }
    }
};
struct EpiRes {
    static constexpr bool PERM = false;
    const GAS float* X; GAS float* O; const GAS float* gate;
    __device__ __forceinline__ void operator()(const f32x4 (&acc)[2][2][4][2], const pg8::Unit& u, int wr, int wc, int fr, int fq) const {
        const int b = u.pm >> 4, col0 = u.pn * 256 + wc * 32 + 4 * fq, row0 = u.pm * 256 + wr * 64 + fr;
        f32x4 gv[2][2];
#pragma unroll
        for (int bj = 0; bj < 2; ++bj)
#pragma unroll
            for (int n = 0; n < 2; ++n) gv[bj][n] = *(const GAS f32x4*)(gate + b * 6144 + col0 + bj * 128 + 16 * n);
#pragma unroll
        for (int ai = 0; ai < 2; ++ai)
#pragma unroll
            for (int m = 0; m < 4; ++m) { const size_t ro = (size_t)(row0 + ai * 128 + m * 16) * 1024 + col0;
#pragma unroll
                for (int bj = 0; bj < 2; ++bj)
#pragma unroll
                    for (int n = 0; n < 2; ++n) { const size_t idx = ro + bj * 128 + 16 * n; const f32x4 xv = *(const GAS f32x4*)(X + idx);
                        *(GAS f32x4*)(O + idx) = xv + gv[bj][n] * acc[ai][bj][m][n]; } }
    }
};
struct EpiGU {
    static constexpr bool PERM = true;
    GAS bf16_t* ACT;
    __device__ __forceinline__ void operator()(const f32x4 (&acc)[2][2][4][2], const pg8::Unit& u, int wr, int wc, int fr, int fq) const {
        const int col0 = u.pn * 128 + wc * 32 + 8 * fq, row0 = u.pm * 256 + wr * 64 + fr;
#pragma unroll
        for (int ai = 0; ai < 2; ++ai)
#pragma unroll
            for (int m = 0; m < 4; ++m) {
                float r[8];
#pragma unroll
                for (int n = 0; n < 2; ++n)
#pragma unroll
                    for (int e = 0; e < 4; ++e) { const float gt = acc[ai][0][m][n][e], up = acc[ai][1][m][n][e]; r[4 * n + e] = gt * __builtin_amdgcn_rcpf(1.f + __expf(-gt)) * up; }
                u32x4 w; w.x = cvt_pk(r[0], r[1]); w.y = cvt_pk(r[2], r[3]); w.z = cvt_pk(r[4], r[5]); w.w = cvt_pk(r[6], r[7]);
                *(GAS u32x4*)(ACT + (size_t)(row0 + ai * 128 + m * 16) * DFF + col0) = w; }
    }
};

template <int MODE> __device__ __forceinline__ int dest_row(int n) {
    if (MODE == 0) { if (n < 1024) return n; if (n < 2560) return 3072 + (n - 1024); if (n < 2576) return -1;
        if (n < 4624) { const int c = n - 2576, base = c < 1024 ? 1024 : 2048, cc = c & 1023, hh = cc >> 6, d = cc & 63;
            return base + 256 * (hh >> 2) + 128 * (d >> 5) + 32 * (hh & 3) + (d & 31); }
        return 4608 + (n - 4624); }
    if (MODE == 1) return n;
    if (MODE == 2) return 256 * (n >> 7) + (n & 127);
    return 256 * (n >> 7) + 128 + (n & 127);
}
template <int MODE> __device__ __forceinline__ void transpose_item(const float* W, int K, int N, bf16_t* WT, LAS float* scr, int item, int lane) {
    const int nblk = (N + 31) / 32, kb = item / nblk, nb = item % nblk, k0 = 64 * kb, n0 = 32 * nb;
    const int nn = n0 + (lane & 31); const bool ok = nn < N;
#pragma unroll
    for (int i = 0; i < 32; ++i) { const int kk = 2 * i + (lane >> 5); scr[kk * 33 + (lane & 31)] = ok ? W[(size_t)(k0 + kk) * N + nn] : 0.f; }
    asm volatile("s_waitcnt lgkmcnt(0)" ::: "memory");
    const int c = lane & 7;
#pragma unroll
    for (int j = 0; j < 4; ++j) { const int n = (lane >> 3) + 8 * j; const LAS float* s = scr + (8 * c) * 33 + n;
        const int dr = (n0 + n < N) ? dest_row<MODE>(n0 + n) : -1;
        u32x4 o; o.x = cvt_pk(s[0 * 33], s[1 * 33]); o.y = cvt_pk(s[2 * 33], s[3 * 33]); o.z = cvt_pk(s[4 * 33], s[5 * 33]); o.w = cvt_pk(s[6 * 33], s[7 * 33]);
        if (dr >= 0) *(u32x4*)(WT + (size_t)dr * K + k0 + 8 * c) = o; }
    asm volatile("s_waitcnt lgkmcnt(0)" ::: "memory");
}

__device__ __forceinline__ void chunk_cumsum(float v0, float v1, int lane, float& s0, float& s1) {
    s0 = v0; s1 = v1;
#pragma unroll
    for (int o = 1; o < 64; o <<= 1) { const float t0 = __shfl_up(s0, o), t1 = __shfl_up(s1, o); if (lane >= o) { s0 += t0; s1 += t1; } }
    s1 += __shfl(s0, 63);
}

__global__ void __launch_bounds__(512, 2) fwd(Params p) {
    extern __shared__ __attribute__((aligned(16))) unsigned char lds_raw[];
    LAS unsigned char* lds = (LAS unsigned char*)lds_raw;
    cg::grid_group grid = cg::this_grid();
    const int lo = p.ph_lo, hi = p.ph_hi;
    if (hi > 1000) grid.sync();
    if (threadIdx.x < 2) ((volatile LAS unsigned*)(lds + 131072))[threadIdx.x] = 0u;
    if (threadIdx.x == 0) (void)xb_add((unsigned*)(p.ws + WS_BAR) + XB_XCNT(xb_xcc_id()), 1u);
    __syncthreads();
#define PHASE_VARS \
    int tid = threadIdx.x; asm volatile("" : "+v"(tid)); \
    const int lane = tid & 63, wave = __builtin_amdgcn_readfirstlane(tid >> 6), fr = lane & 15, fq = lane >> 4; \
    int G = gridDim.x; asm volatile("" : "+s"(G)); \
    const int gw = blockIdx.x * 8 + wave, NGW = G * 8; \
    unsigned char* ws = p.ws; asm volatile("" : "+s"(ws)); \
    float* out = p.out; asm volatile("" : "+s"(out)); \
    (void)lane; (void)wave; (void)fr; (void)fq; (void)gw; (void)NGW; (void)ws; (void)out;
#define P_MODP ((float*)(ws + WS_MODP))
#define P_MOD ((float*)(ws + WS_MOD))
#define P_CDEC ((float*)(ws + WS_CDEC))
#define P_WIN ((bf16_t*)(ws + WS_WIN))
#define P_WOUT ((bf16_t*)(ws + WS_WOUT))
#define P_WGU ((bf16_t*)(ws + WS_WGU))
#define P_WDN ((bf16_t*)(ws + WS_WDN))
#define P_DT ((float*)(ws + WS_DT))
#define P_HB ((bf16_t*)(ws + WS_H))
#define P_PROJ ((bf16_t*)(ws + WS_PROJ))
#define P_VT ((bf16_t*)(ws + WS_VT))
#define P_XBC ((bf16_t*)(ws + WS_XBC))
#define P_ST ((bf16_t*)(ws + WS_ST))
#define P_ACT ((bf16_t*)(ws + WS_ACT))
#define P_XC ((bf16_t*)out)
#define P_BC ((bf16_t*)((unsigned char*)out + 32 * MiB))
#define P_BT ((bf16_t*)((unsigned char*)out + 48 * MiB))
#define IN(k) (lo <= (k) && (k) < hi)
#define GRID_BAR() xcd_barrier((unsigned*)(p.ws + WS_BAR), (volatile LAS unsigned*)(lds + 131072))
#define SEAM(k) do { if (IN(k) && IN((k) + 1)) GRID_BAR(); } while (0)

    if (IN(0)) {
        PHASE_VARS
        LAS float* cond = (LAS float*)(lds + 70000 / 16 * 16);
        for (int it = blockIdx.x; it < 192; it += G) {
            const int kc = it / 12, cb = it % 12, j = cb * 512 + tid;
            __syncthreads();
            if (tid < 256) { const int b = tid >> 6, k = kc * 64 + (tid & 63); const float cv = (p.in[1])[b * 1024 + k]; cond[tid] = cv / (1.f + expf(-cv)); }
            __syncthreads();
            float a0 = 0.f, a1 = 0.f, a2 = 0.f, a3 = 0.f;
#pragma unroll 16
            for (int k = 0; k < 64; ++k) { const float w = (p.in[2])[(size_t)(kc * 64 + k) * 6144 + j]; a0 += cond[k] * w; a1 += cond[64 + k] * w; a2 += cond[128 + k] * w; a3 += cond[192 + k] * w; }
            P_MODP[(kc * 4 + 0) * 6144 + j] = a0; P_MODP[(kc * 4 + 1) * 6144 + j] = a1; P_MODP[(kc * 4 + 2) * 6144 + j] = a2; P_MODP[(kc * 4 + 3) * 6144 + j] = a3;
        }
        LAS float* scr = (LAS float*)lds + wave * (64 * 33);
        constexpr int I_IN = 16 * 177, I_OUT = 32 * 32, I_G = 16 * 88, I_DN = 44 * 32;
        for (int it = gw; it < I_IN + I_OUT + 2 * I_G + I_DN; it += NGW) {
            int r = it;
            if (r < I_IN) { transpose_item<0>((p.in[5]), 1024, DIN, P_WIN, scr, r, lane); continue; } r -= I_IN;
            if (r < I_OUT) { transpose_item<1>((p.in[14]), 2048, 1024, P_WOUT, scr, r, lane); continue; } r -= I_OUT;
            if (r < I_G) { transpose_item<2>((p.in[16]), 1024, DFF, P_WGU, scr, r, lane); continue; } r -= I_G;
            if (r < I_G) { transpose_item<3>((p.in[17]), 1024, DFF, P_WGU, scr, r, lane); continue; } r -= I_G;
            transpose_item<1>((p.in[18]), DFF, 1024, P_WDN, scr, r, lane);
        }
    }
    SEAM(0);

    if (IN(1)) {
        PHASE_VARS
        LAS float* wdt = (LAS float*)lds; LAS float* scl = wdt + 16 * 1028; LAS float* shf = scl + 1024;
        __syncthreads();
        for (int i = tid; i < 16384; i += 512) { const int k = i >> 4, ii = i & 15; wdt[ii * 1028 + k] = ((const GAS float*)(p.in[5]))[(size_t)k * DIN + 2560 + ii]; }
        for (int i = blockIdx.x * 512 + tid; i < 24576; i += G * 512) { float s = (p.in[3])[i % 6144];
#pragma unroll
            for (int kc = 0; kc < 16; ++kc) s += P_MODP[kc * 24576 + i];
            P_MOD[i] = s; }
        for (int rb = blockIdx.x; rb < 256; rb += G) {
            const int b = rb >> 6;
            __syncthreads();
            for (int k = tid; k < 1024; k += 512) { float sh = (p.in[3])[k], sc = (p.in[3])[1024 + k];
#pragma unroll
                for (int kc = 0; kc < 16; ++kc) { sh += P_MODP[(kc * 4 + b) * 6144 + k]; sc += P_MODP[(kc * 4 + b) * 6144 + 1024 + k]; }
                scl[k] = (p.in[4])[k] * (1.f + sc); shf[k] = sh; }
            __syncthreads();
            f32x4 vnx[2][4];
#pragma unroll
            for (int q = 0; q < 2; ++q)
#pragma unroll
                for (int j = 0; j < 4; ++j) vnx[q][j] = *(const GAS f32x4*)((const GAS float*)p.in[0] + (size_t)(rb * 64 + wave + 8 * q) * 1024 + 4 * lane + 256 * j);
            for (int r = wave; r < 64; r += 16) {
                const int row0_ = rb * 64 + r;
                f32x4 v[2][4]; float ss[2] = {0.f, 0.f};
#pragma unroll
                for (int q = 0; q < 2; ++q)
#pragma unroll
                    for (int j = 0; j < 4; ++j) { v[q][j] = vnx[q][j];
                        ss[q] += (v[q][j].x * v[q][j].x + v[q][j].y * v[q][j].y) + (v[q][j].z * v[q][j].z + v[q][j].w * v[q][j].w); }
                { const int rn = r + 16 < 64 ? r + 16 : r;
#pragma unroll
                  for (int q = 0; q < 2; ++q)
#pragma unroll
                    for (int j = 0; j < 4; ++j) vnx[q][j] = *(const GAS f32x4*)((const GAS float*)p.in[0] + (size_t)(rb * 64 + rn + 8 * q) * 1024 + 4 * lane + 256 * j); }
                __builtin_amdgcn_sched_barrier(0);
#pragma unroll
                for (int q = 0; q < 2; ++q) {
                    const int row = row0_ + 8 * q;
                    const float rstd = 1.0f / sqrtf(wave_sum(ss[q]) * (1.f / 1024.f) + 1e-6f);
#pragma unroll
                    for (int j = 0; j < 4; ++j) { const int k = 4 * lane + 256 * j; const f32x4 s4 = *(const LAS f32x4*)(scl + k), t4 = *(const LAS f32x4*)(shf + k);
                        v[q][j] = v[q][j] * rstd * s4 + t4;
                        u32x2 w; w.x = cvt_pk(v[q][j].x, v[q][j].y); w.y = cvt_pk(v[q][j].z, v[q][j].w);
                        *(GAS u32x2*)((GAS bf16_t*)P_HB + (size_t)row * 1024 + k) = w; }
                }
                float pa[16], pb[16];
#pragma unroll
                for (int ii = 0; ii < 16; ++ii) { float a0 = 0.f, a1 = 0.f;
#pragma unroll
                    for (int j = 0; j < 4; ++j) { const f32x4 w4 = *(const LAS f32x4*)(wdt + ii * 1028 + 4 * lane + 256 * j);
                        a0 += (v[0][j].x * w4.x + v[0][j].y * w4.y) + (v[0][j].z * w4.z + v[0][j].w * w4.w);
                        a1 += (v[1][j].x * w4.x + v[1][j].y * w4.y) + (v[1][j].z * w4.z + v[1][j].w * w4.w); }
                    pa[ii] = a0; pb[ii] = a1; }
                const int oi = ((lane >> 5) & 1) * 8 + ((lane >> 4) & 1) * 4 + ((lane >> 3) & 1) * 2 + ((lane >> 2) & 1);
                const float dtb = (p.in[8])[oi];
#pragma unroll
                for (int st = 0; st < 4; ++st) { const int msk = 32 >> st, cnt = 8 >> st; const bool up = (lane & msk) != 0;
#pragma unroll
                    for (int i = 0; i < 8; ++i) if (i < cnt) {
                        { const float keep = up ? pa[i + cnt] : pa[i], send = up ? pa[i] : pa[i + cnt]; pa[i] = keep + __shfl_xor(send, msk); }
                        { const float keep = up ? pb[i + cnt] : pb[i], send = up ? pb[i] : pb[i + cnt]; pb[i] = keep + __shfl_xor(send, msk); } } }
                float t0 = pa[0], t1 = pb[0]; t0 += __shfl_xor(t0, 2); t1 += __shfl_xor(t1, 2); t0 += __shfl_xor(t0, 1); t1 += __shfl_xor(t1, 1);
                if ((lane & 3) == 0) { const float z0 = t0 + dtb, z1 = t1 + dtb;
                    P_DT[(size_t)row0_ * 16 + oi] = z0 > 20.f ? z0 : log1pf(expf(z0)); P_DT[(size_t)(row0_ + 8) * 16 + oi] = z1 > 20.f ? z1 : log1pf(expf(z1)); }
            }
        }
    }
    SEAM(1);

    if (IN(2)) {
        PHASE_VARS
        __syncthreads();
        { pg8::Gemm g{P_HB, P_WIN, MT, 4608, 1024, 1024}; pg8::StaticOrder S; S.init(MT, 4608, G, (int)blockIdx.x); EpiProj E{(GAS bf16_t*)P_PROJ, (GAS bf16_t*)P_XBC, (const GAS float*)p.in[12], (const GAS float*)p.in[13], (GAS bf16_t*)out};
          pg8::gemm_phase<EpiProj, true>(lds, g, S, E); }
        { pg8::Gemm g{P_WIN + (size_t)4608 * 1024, P_HB, 1024, MT, 1024, 1024}; pg8::StaticOrder S; S.init(1024, MT, G, (int)blockIdx.x); EpiVT E{(GAS bf16_t*)P_VT};
          pg8::gemm_phase<EpiVT, true>(lds, g, S, E); }
    }
    SEAM(2);

    if (IN(3)) {
        PHASE_VARS
        __syncthreads();
        LAS bf16_t* tile = (LAS bf16_t*)lds + wave * (64 * 72);
        for (int un = blockIdx.x; un < 256; un += G)
        for (int j = wave; j < 24; j += 8) {
            const int b = un >> 6, c_ = (un >> 1) & 31, g_ = un & 1, tbl = j / 12, cl = j % 12;
            const int cb = cl < 8 ? 8 * g_ + cl : (cl < 10 ? 16 + 2 * g_ + (cl - 8) : 20 + 2 * g_ + (cl - 10)), tb = 2 * c_ + tbl;
            const int ch = cb * 64 + lane;
            const float w0 = (p.in[6])[ch], w1 = (p.in[6])[1536 + ch], w2 = (p.in[6])[3072 + ch], w3 = (p.in[6])[4608 + ch], bs = (p.in[7])[ch];
            const bf16_t* src = P_XBC + ((size_t)b * 4096 + tb * 64) * 1536 + ch;
            const GAS bf16_t* srcg = (const GAS bf16_t*)src;
            float u0 = 0.f, u1 = 0.f, u2 = 0.f;
            if (tb > 0) { u0 = bf2f(srcg[-3 * 1536]); u1 = bf2f(srcg[-2 * 1536]); u2 = bf2f(srcg[-1536]); }
            bf16_t raw[64];
#pragma unroll
            for (int t = 0; t < 64; ++t) raw[t] = srcg[(size_t)t * 1536];
            bf16_t* dstn; int ldn;
            if (cb < 16) { dstn = P_XC + ((size_t)b * 4096 + tb * 64) * 1024 + ch; ldn = 1024; } else { dstn = P_BC + ((size_t)b * 4096 + tb * 64) * 512 + (ch - 1024); ldn = 512; }
            GAS bf16_t* dstg = (GAS bf16_t*)dstn;
            const f32x2_t W0 = {w0, w0}, W1 = {w1, w1}, W2 = {w2, w2}, W3 = {w3, w3}, BS = {bs, bs};
#pragma unroll
            for (int t = 0; t < 64; t += 2) {
                const float u3 = bf2f(raw[t]), u4 = bf2f(raw[t + 1]);
                const f32x2_t A0 = {u0, u1}, A1 = {u1, u2}, A2 = {u2, u3}, A3 = {u3, u4};
                const f32x2_t v = BS + W0 * A0 + W1 * A1 + W2 * A2 + W3 * A3;
                const f32x2_t e = v * (-1.44269504089f);
                f32x2_t d; d.x = 1.f + __builtin_amdgcn_exp2f(e.x); d.y = 1.f + __builtin_amdgcn_exp2f(e.y);
                f32x2_t r; r.x = __builtin_amdgcn_rcpf(d.x); r.y = __builtin_amdgcn_rcpf(d.y);
                const f32x2_t y = v * r;
                const unsigned pk = cvt_pk(y.x, y.y);
                if (cb >= 16) { dstg[(size_t)t * ldn] = (bf16_t)(pk & 0xffffu); dstg[(size_t)(t + 1) * ldn] = (bf16_t)(pk >> 16); }
                ((LAS unsigned*)tile)[lane * 34 + (t >> 1)] = pk;
                u0 = u2; u1 = u3; u2 = u4;
            }
            asm volatile("s_waitcnt lgkmcnt(0)" ::: "memory");
            if (cb < 20) {
#pragma unroll
                for (int i = 0; i < 8; ++i) { const int r = i * 8 + (lane >> 3), cc = lane & 7;
                    const u32x2 va = *(const LAS u32x2*)(tile + r * 68 + cc * 8), vb = *(const LAS u32x2*)(tile + r * 68 + cc * 8 + 4);
                    u32x4 val; val.x = va.x; val.y = va.y; val.z = vb.x; val.w = vb.y;
                    bf16_t* dp;
                    if (cb < 16) dp = P_HB + (((((size_t)(b * 16 + cb) * 128 + tb * 2 + (cc >> 2)) * 4 + (r >> 4)) * 64) + (cc & 3) * 16 + (r & 15)) * 8;
                    else { const int ng = (cb - 16) * 64 + r, nn = ng & 127; dp = P_BT + (((((size_t)(b * 2 + (ng >> 7)) * 128 + tb * 2 + (cc >> 2)) * 8 + (nn >> 4)) * 64) + (cc & 3) * 16 + (nn & 15)) * 8; }
                    *(u32x4*)dp = val; }
            }
            asm volatile("s_waitcnt lgkmcnt(0)" ::: "memory");
        }
    }

    if (IN(4)) {
        PHASE_VARS
        for (int un = blockIdx.x; un < 256; un += G) {
            const int b = un >> 6, c = (un >> 1) & 31, g = un & 1, h = g * 8 + wave;
            LAS float* wl = (LAS float*)lds + wave * 128;
            asm volatile("s_waitcnt vmcnt(0)" ::: "memory");
            __syncthreads();
            const float ah = -expf((p.in[9])[h]);
            const size_t tok0 = (size_t)b * 4096 + c * 128;
            const float dt0 = ((const GAS float*)P_DT)[(tok0 + lane) * 16 + h], dt1 = ((const GAS float*)P_DT)[(tok0 + 64 + lane) * 16 + h];
            float s0, s1; chunk_cumsum(ah * dt0, ah * dt1, lane, s0, s1);
            const float last = __shfl(s1, 63);
            wl[lane] = expf(last - s0) * dt0; wl[64 + lane] = expf(last - s1) * dt1;
            if (lane == 0) P_CDEC[(b * 32 + c) * 16 + h] = expf(last);
            __syncthreads();
            f32x4 acc[4][8];
#pragma unroll
            for (int mi = 0; mi < 4; ++mi)
#pragma unroll
                for (int ni = 0; ni < 8; ++ni) acc[mi][ni] = (f32x4){0.f, 0.f, 0.f, 0.f};
            const GAS bf16_t* xt = (const GAS bf16_t*)P_HB + (((size_t)(b * 16 + h) * 128 + c * 4) * 4) * 512 + lane * 8;
            const GAS bf16_t* bt = (const GAS bf16_t*)P_BT + (((size_t)(b * 2 + g) * 128 + c * 4) * 8) * 512 + lane * 8;
#pragma unroll 2
            for (int ks = 0; ks < 4; ++ks) {
                const f32x4 wa = *(const LAS f32x4*)(wl + 32 * ks + 8 * fq), wb = *(const LAS f32x4*)(wl + 32 * ks + 8 * fq + 4);
                bf16x8 xf[4];
#pragma unroll
                for (int mi = 0; mi < 4; ++mi) { const u32x4 raw = *(const GAS u32x4*)(xt + (ks * 4 + mi) * 512); u32x4 o;
                    o.x = cvt_pk(bflo(raw.x) * wa.x, bfhi(raw.x) * wa.y); o.y = cvt_pk(bflo(raw.y) * wa.z, bfhi(raw.y) * wa.w);
                    o.z = cvt_pk(bflo(raw.z) * wb.x, bfhi(raw.z) * wb.y); o.w = cvt_pk(bflo(raw.w) * wb.z, bfhi(raw.w) * wb.w);
                    xf[mi] = __builtin_bit_cast(bf16x8, o); }
#pragma unroll
                for (int ni = 0; ni < 8; ++ni) { const bf16x8 bf = *(const GAS bf16x8*)(bt + (ks * 8 + ni) * 512);
#pragma unroll
                    for (int mi = 0; mi < 4; ++mi) acc[mi][ni] = MFMA16(bf, xf[mi], acc[mi][ni]); }
            }
            GAS bf16_t* st = (GAS bf16_t*)P_ST + ((size_t)((b * 32 + c) * 16 + h) * 64) * 128;
#pragma unroll
            for (int mi = 0; mi < 4; ++mi)
#pragma unroll
                for (int ni = 0; ni < 8; ++ni) { u32x2 w; w.x = cvt_pk(acc[mi][ni][0], acc[mi][ni][1]); w.y = cvt_pk(acc[mi][ni][2], acc[mi][ni][3]);
                    *(GAS u32x2*)(st + ((mi * 4 + (ni >> 1)) * 64 + (2 * (ni & 1) + (fq >> 1)) * 16 + fr) * 8 + 4 * (fq & 1)) = w; }
        }
    }
    SEAM(4);

    if (IN(5)) {
        PHASE_VARS
        unsigned* ST32 = (unsigned*)P_ST;
        for (int gid = blockIdx.x * 512 + tid; gid < 262144; gid += G * 512) {
            const int b = gid >> 16, rem = gid & 65535, h = rem >> 12, pn = rem & 4095;
            const GAS unsigned* sg = (const GAS unsigned*)ST32 + ((size_t)(b * 32 * 16 + h)) * 4096 + pn;
            const GAS float* dg = (const GAS float*)P_CDEC + b * 32 * 16 + h;
            unsigned vv[32]; float dd[32];
#pragma unroll
            for (int c = 0; c < 32; ++c) { vv[c] = sg[(size_t)c * 16 * 4096]; dd[c] = dg[c * 16]; }
            float r0 = 0.f, r1 = 0.f;
#pragma unroll
            for (int c = 0; c < 32; ++c) {
                ((GAS unsigned*)sg)[(size_t)c * 16 * 4096] = cvt_pk(r0, r1);
                r0 = r0 * dd[c] + bflo(vv[c]); r1 = r1 * dd[c] + bfhi(vv[c]);
            }
        }
    }
    SEAM(5);

    if (IN(6)) {
        PHASE_VARS
#ifndef SKIP_S3
        for (int un = blockIdx.x; un < 256; un += G) {
            const int b = un >> 6, c = (un >> 1) & 31, g = un & 1, h = g * 8 + wave;
            LAS float* SC = (LAS float*)lds;
            LAS float* acsl = SC + 128 * 132 + wave * 256;
            LAS float* ssqp = SC + 128 * 132 + 8 * 256;
            const size_t tok0 = (size_t)b * 4096 + c * 128;
            __syncthreads();
            {
                f32x4 sacc[8];
#pragma unroll
                for (int ni = 0; ni < 8; ++ni) sacc[ni] = (f32x4){0.f, 0.f, 0.f, 0.f};
                const GAS bf16_t* cp = (const GAS bf16_t*)P_BC + (tok0 + 16 * wave + fr) * 512 + 256 + g * 128 + 8 * fq;
                const GAS bf16_t* bp = (const GAS bf16_t*)P_BC + (tok0 + fr) * 512 + g * 128 + 8 * fq;
#pragma unroll 2
                for (int ks = 0; ks < 4; ++ks) { const bf16x8 cf = *(const GAS bf16x8*)(cp + 32 * ks);
#pragma unroll
                    for (int ni = 0; ni < 8; ++ni) if (ni <= wave) { const bf16x8 bf = *(const GAS bf16x8*)(bp + (size_t)ni * 16 * 512 + 32 * ks); sacc[ni] = MFMA16(cf, bf, sacc[ni]); } }
#pragma unroll
                for (int ni = 0; ni < 8; ++ni) if (ni <= wave) {
#pragma unroll
                    for (int r = 0; r < 4; ++r) SC[(16 * wave + 4 * fq + r) * 132 + 16 * ni + fr] = sacc[ni][r]; }
            }
            const float ah = -expf((p.in[9])[h]);
            {
                const float dt0 = ((const GAS float*)P_DT)[(tok0 + lane) * 16 + h], dt1 = ((const GAS float*)P_DT)[(tok0 + 64 + lane) * 16 + h];
                float s0, s1; chunk_cumsum(ah * dt0, ah * dt1, lane, s0, s1);
                acsl[lane] = s0; acsl[64 + lane] = s1; acsl[128 + lane] = dt0; acsl[192 + lane] = dt1;
            }
            __syncthreads();
            f32x4 acc[8][4];
#pragma unroll
            for (int mi = 0; mi < 8; ++mi)
#pragma unroll
                for (int ni = 0; ni < 4; ++ni) acc[mi][ni] = (f32x4){0.f, 0.f, 0.f, 0.f};
            {
                const GAS bf16_t* pv = (const GAS bf16_t*)P_ST + ((size_t)((b * 32 + c) * 16 + h) * 64) * 128 + lane * 8;
                const GAS bf16_t* cq = (const GAS bf16_t*)P_BC + (tok0 + fr) * 512 + 256 + g * 128 + 8 * fq;
#pragma unroll 2
                for (int ks = 0; ks < 4; ++ks) { bf16x8 pf[4];
#pragma unroll
                    for (int ni = 0; ni < 4; ++ni) pf[ni] = *(const GAS bf16x8*)(pv + (ni * 4 + ks) * 512);
#pragma unroll
                    for (int mi = 0; mi < 8; ++mi) { const bf16x8 cf = *(const GAS bf16x8*)(cq + (size_t)mi * 16 * 512 + 32 * ks);
#pragma unroll
                        for (int ni = 0; ni < 4; ++ni) acc[mi][ni] = MFMA16(pf[ni], cf, acc[mi][ni]); } }
#pragma unroll
                for (int mi = 0; mi < 8; ++mi) { const float e = __expf(acsl[16 * mi + fr]);
#pragma unroll
                    for (int ni = 0; ni < 4; ++ni) acc[mi][ni] = acc[mi][ni] * e; }
            }
            const float Dh = (p.in[10])[h];
            {
                const GAS bf16_t* xt = (const GAS bf16_t*)P_HB + (((size_t)(b * 16 + h) * 128 + c * 4) * 4) * 512 + lane * 8;
#pragma unroll 1
                for (int ks = 0; ks < 4; ++ks) { bf16x8 xf[4];
#pragma unroll
                    for (int ni = 0; ni < 4; ++ni) xf[ni] = *(const GAS bf16x8*)(xt + (ks * 4 + ni) * 512);
                    float as_[8], ds_[8];
#pragma unroll
                    for (int i = 0; i < 8; ++i) { as_[i] = acsl[32 * ks + 8 * fq + i]; ds_[i] = acsl[128 + 32 * ks + 8 * fq + i]; }
#pragma unroll
                    for (int mi = 0; mi < 8; ++mi) if (16 * mi + 15 >= 32 * ks) {
                        const int l = 16 * mi + fr; const float al = acsl[l];
                        const f32x4 g0 = *(const LAS f32x4*)(SC + l * 132 + 32 * ks + 8 * fq), g1 = *(const LAS f32x4*)(SC + l * 132 + 32 * ks + 8 * fq + 4);
                        float gv[8];
#pragma unroll
                        for (int i = 0; i < 8; ++i) { const int s = 32 * ks + 8 * fq + i; const float sc = i < 4 ? g0[i & 3] : g1[i & 3];
                            const float val = sc * __expf(al - as_[i]) * ds_[i]; gv[i] = (s <= l) ? val : 0.f; if (s == l) gv[i] += Dh; }
                        u32x4 o; o.x = cvt_pk(gv[0], gv[1]); o.y = cvt_pk(gv[2], gv[3]); o.z = cvt_pk(gv[4], gv[5]); o.w = cvt_pk(gv[6], gv[7]);
                        const bf16x8 gf = __builtin_bit_cast(bf16x8, o);
#pragma unroll
                        for (int ni = 0; ni < 4; ++ni) acc[mi][ni] = MFMA16(xf[ni], gf, acc[mi][ni]); }
                }
            }
            {
#pragma unroll
                for (int mi = 0; mi < 8; ++mi) { const int l = 16 * mi + fr; const size_t tok = tok0 + l; float s = 0.f;
#pragma unroll
                    for (int ni = 0; ni < 4; ++ni) { const int ch = h * 64 + 16 * ni + 4 * fq;
                        const u32x2 zz = *(const GAS u32x2*)((const GAS bf16_t*)P_PROJ + tok * 3072 + ch);
                        const float zv[4] = {bflo(zz.x), bfhi(zz.x), bflo(zz.y), bfhi(zz.y)};
#pragma unroll
                        for (int e = 0; e < 4; ++e) { float y = acc[mi][ni][e]; y *= zv[e] * __builtin_amdgcn_rcpf(1.f + __expf(-zv[e])); acc[mi][ni][e] = y; s += y * y; } }
                    s += __shfl_xor(s, 16); s += __shfl_xor(s, 32);
                    if (fq == 0) ssqp[wave * 128 + l] = s; }
                __syncthreads();
#pragma unroll
                for (int mi = 0; mi < 8; ++mi) { const int l = 16 * mi + fr; const size_t tok = tok0 + l; float tot = 0.f;
#pragma unroll
                    for (int w = 0; w < 8; ++w) tot += ssqp[w * 128 + l];
                    const float rstd = 1.0f / sqrtf(tot * (1.f / 512.f) + 1e-6f);
#pragma unroll
                    for (int ni = 0; ni < 4; ++ni) { const int ch = h * 64 + 16 * ni + 4 * fq; const f32x4 nw4 = *(const GAS f32x4*)((const GAS float*)(p.in[11]) + ch);
                        u32x2 w; w.x = cvt_pk(acc[mi][ni][0] * rstd * nw4.x, acc[mi][ni][1] * rstd * nw4.y); w.y = cvt_pk(acc[mi][ni][2] * rstd * nw4.z, acc[mi][ni][3] * rstd * nw4.w);
                        *(GAS u32x2*)((GAS bf16_t*)P_PROJ + tok * 3072 + ch) = w; } }
            }
        }
#endif
#ifndef SKIP_ATT
        for (int it = 0;; ++it) {
            int qt, bh;
            if ((G & 7) == 0) {
                int uidx = 0;
                if (lane == 0) uidx = (int)__hip_atomic_fetch_add((unsigned*)(p.ws + WS_BAR) + 3520 + 64 * (blockIdx.x & 7), 1u, __ATOMIC_RELAXED, __HIP_MEMORY_SCOPE_AGENT);
                uidx = __builtin_amdgcn_readfirstlane(uidx);
                if (uidx >= 1024) break; qt = uidx & 127; bh = (blockIdx.x & 7) + 8 * (uidx >> 7); }
            else { const int wu = gw + it * NGW; if (wu >= 8192) break; qt = wu & 127; bh = wu >> 7; }
            const int b = bh >> 4, h = bh & 15, q0 = qt * 32;
            bf16_t* qp = P_PROJ + ((size_t)b * 4096 + q0 + fr) * 3072 + 1024 + h * 64;
            const GAS bf16_t* qg = (const GAS bf16_t*)qp;
            bf16x8 qf[2][2];
#pragma unroll
            for (int t = 0; t < 2; ++t) { qf[t][0] = *(const GAS bf16x8*)(qg + (size_t)t * 16 * 3072 + 8 * fq); qf[t][1] = *(const GAS bf16x8*)(qg + (size_t)t * 16 * 3072 + 32 + 8 * fq); }
            f32x4 o[2][4];
#pragma unroll
            for (int t = 0; t < 2; ++t)
#pragma unroll
                for (int di = 0; di < 4; ++di) o[t][di] = (f32x4){0.f, 0.f, 0.f, 0.f};
            float carry[2] = {0.f, 0.f};
            const GAS bf16_t* kbase = (const GAS bf16_t*)out + (size_t)bh * (256 * 1024) + lane * 8;
            const GAS bf16_t* vbase = (const GAS bf16_t*)P_VT + (size_t)bh * (128 * 2048) + lane * 8;
            int kb = (q0 + 30) >> 6;
            bf16x8 kc[8];
#pragma unroll
            for (int ki = 0; ki < 4; ++ki) { const GAS bf16_t* kp = kbase + (size_t)(kb * 4 + ki) * 1024; kc[2 * ki] = *(const GAS bf16x8*)kp; kc[2 * ki + 1] = *(const GAS bf16x8*)(kp + 512); }
            for (;;) {
                const int j0 = kb * 64;
                bf16x8 vv[8];
#pragma unroll
                for (int kk = 0; kk < 2; ++kk)
#pragma unroll
                    for (int di = 0; di < 4; ++di) vv[kk * 4 + di] = *(const GAS bf16x8*)(vbase + (size_t)(((j0 >> 5) + kk) * 4 + di) * 512);
                bf16x8 kn[8];
                { const int jn = (kb > 0 ? kb - 1 : 0) * 64;
#pragma unroll
                  for (int ki = 0; ki < 4; ++ki) { const GAS bf16_t* kp = kbase + (size_t)((jn >> 4) + ki) * 1024; kn[2 * ki] = *(const GAS bf16x8*)kp; kn[2 * ki + 1] = *(const GAS bf16x8*)(kp + 512); } }
                const bool diag = j0 + 63 >= q0;
#pragma unroll
                for (int t = 0; t < 2; ++t) {
                    const int qlim = diag ? q0 + 16 * t + fr : 0x7fffffff;
                    f32x4 s[4];
#pragma unroll
                    for (int ki = 0; ki < 4; ++ki) { s[ki] = MFMA16(kc[2 * ki], qf[t][0], ((f32x4){0.f, 0.f, 0.f, 0.f})); s[ki] = MFMA16(kc[2 * ki + 1], qf[t][1], s[ki]); }
                    float sp[4][4], lw[4][4], gs[4], rowtot[4], above[4];
#pragma unroll
                    for (int ki = 0; ki < 4; ++ki) {
#pragma unroll
                        for (int r = 0; r < 4; ++r) { const float l = s[ki][r];
                            const float spv = fmaxf(l, 0.f) + __builtin_amdgcn_logf(1.f + __builtin_amdgcn_exp2f(-fabsf(l)));
                            const int key = j0 + 16 * ki + 4 * fq + r;
                            sp[ki][r] = key < qlim ? spv : 0.f; lw[ki][r] = l - spv; }
                        gs[ki] = (sp[ki][0] + sp[ki][1]) + (sp[ki][2] + sp[ki][3]);
                        const float g16 = __shfl_xor(gs[ki], 16), g32 = __shfl_xor(gs[ki], 32), g48 = __shfl_xor(gs[ki], 48);
                        rowtot[ki] = (gs[ki] + g16) + (g32 + g48);
                        above[ki] = ((fq ^ 1) > fq ? g16 : 0.f) + ((fq ^ 2) > fq ? g32 : 0.f) + ((fq ^ 3) > fq ? g48 : 0.f);
                    }
                    float run = carry[t]; float wv[4][4];
#pragma unroll
                    for (int ki = 3; ki >= 0; --ki) { const float r3 = run + above[ki], r2 = r3 + sp[ki][3], r1 = r2 + sp[ki][2], r0 = r1 + sp[ki][1];
                        const int key0 = j0 + 16 * ki + 4 * fq;
                        wv[ki][3] = key0 + 3 < qlim ? __builtin_amdgcn_exp2f(lw[ki][3] - r3) : 0.f; wv[ki][2] = key0 + 2 < qlim ? __builtin_amdgcn_exp2f(lw[ki][2] - r2) : 0.f;
                        wv[ki][1] = key0 + 1 < qlim ? __builtin_amdgcn_exp2f(lw[ki][1] - r1) : 0.f; wv[ki][0] = key0 < qlim ? __builtin_amdgcn_exp2f(lw[ki][0] - r0) : 0.f;
                        run += rowtot[ki]; }
                    carry[t] = run;
#pragma unroll
                    for (int kk = 0; kk < 2; ++kk) { u32x4 pw; pw.x = cvt_pk(wv[2 * kk][0], wv[2 * kk][1]); pw.y = cvt_pk(wv[2 * kk][2], wv[2 * kk][3]);
                        pw.z = cvt_pk(wv[2 * kk + 1][0], wv[2 * kk + 1][1]); pw.w = cvt_pk(wv[2 * kk + 1][2], wv[2 * kk + 1][3]);
                        const bf16x8 pf = __builtin_bit_cast(bf16x8, pw);
#pragma unroll
                        for (int di = 0; di < 4; ++di) o[t][di] = MFMA16(vv[kk * 4 + di], pf, o[t][di]); }
                }
                if (kb == 0 || __all(fminf(carry[0], carry[1]) > 57.71f)) break;
                --kb;
#pragma unroll
                for (int i = 0; i < 8; ++i) kc[i] = kn[i];
            }
#pragma unroll
            for (int t = 0; t < 2; ++t)
#pragma unroll
                for (int di = 0; di < 4; ++di) { u32x2 w; w.x = cvt_pk(o[t][di][0], o[t][di][1]); w.y = cvt_pk(o[t][di][2], o[t][di][3]);
                    *(GAS u32x2*)((GAS bf16_t*)qp + (size_t)t * 16 * 3072 + 16 * di + 4 * fq) = w; }
        }
#endif
    }
    SEAM(6);

    if (IN(7)) {
        PHASE_VARS
        __syncthreads();
        pg8::Gemm g{P_PROJ, P_WOUT, MT, 1024, 2048, 3072}; pg8::StaticOrder S; S.init(MT, 1024, G, (int)blockIdx.x); EpiRes E{(const GAS float*)p.in[0], (GAS float*)out, (const GAS float*)(P_MOD + 2048)};
        pg8::gemm_phase<EpiRes, true>(lds, g, S, E);
    }
    SEAM(7);

    if (IN(8)) {
        PHASE_VARS
        for (int row0_ = gw; row0_ < MT; row0_ += 2 * NGW) {
            f32x4 v[2][4]; float ss[2] = {0.f, 0.f};
#pragma unroll
            for (int q = 0; q < 2; ++q)
#pragma unroll
                for (int j = 0; j < 4; ++j) { const int row = row0_ + q * NGW < MT ? row0_ + q * NGW : row0_;
                    v[q][j] = *(const GAS f32x4*)((const GAS float*)out + (size_t)row * 1024 + 4 * lane + 256 * j);
                    ss[q] += (v[q][j].x * v[q][j].x + v[q][j].y * v[q][j].y) + (v[q][j].z * v[q][j].z + v[q][j].w * v[q][j].w); }
#pragma unroll
            for (int q = 0; q < 2; ++q) { const int row = row0_ + q * NGW; if (row < MT) {
                const int b = row >> 12;
                const float rstd = 1.0f / sqrtf(wave_sum(ss[q]) * (1.f / 1024.f) + 1e-6f);
#pragma unroll
                for (int j = 0; j < 4; ++j) { const int k = 4 * lane + 256 * j;
                    const f32x4 nw = *(const f32x4*)((p.in[15]) + k), sc = *(const f32x4*)(P_MOD + b * 6144 + 4096 + k), sh = *(const f32x4*)(P_MOD + b * 6144 + 3072 + k);
                    const f32x4 hv = v[q][j] * rstd * nw * (sc + 1.f) + sh;
                    u32x2 w; w.x = cvt_pk(hv.x, hv.y); w.y = cvt_pk(hv.z, hv.w);
                    *(GAS u32x2*)((GAS bf16_t*)P_HB + (size_t)row * 1024 + k) = w; } } }
        }
    }
    SEAM(8);

    if (IN(9)) {
        PHASE_VARS
        __syncthreads();
        pg8::Gemm g{P_HB, P_WGU, MT, 5632, 1024, 1024}; pg8::StaticOrder S; S.init(MT, 5632, G, (int)blockIdx.x); EpiGU E{(GAS bf16_t*)P_ACT};
        pg8::gemm_phase<EpiGU, true>(lds, g, S, E);
    }
    SEAM(9);

    if (IN(10)) {
        PHASE_VARS
        __syncthreads();
        pg8::Gemm g{P_ACT, P_WDN, MT, 1024, DFF, DFF}; pg8::StaticOrder S; S.init(MT, 1024, G, (int)blockIdx.x); EpiRes E{(const GAS float*)out, (GAS float*)out, (const GAS float*)(P_MOD + 5120)};
        pg8::gemm_phase<EpiRes, true>(lds, g, S, E);
    }

#ifdef DBG_HI
    GRID_BAR();
    {   PHASE_VARS
        for (size_t i = (size_t)blockIdx.x * 512 + tid; i < (size_t)MT * 1024; i += (size_t)G * 512) {
            const size_t m = i >> 10, c = i & 1023;
            out[i] = DBG_EXPR;
        }
    }
#endif
#undef IN
#undef SEAM
}

extern "C" void kernel_launch(void* const* d_in, const int* in_sizes, int n_in, void* d_out, int out_size, void* d_ws, size_t ws_size, hipStream_t stream) {
    static int grid = 0;
    if (grid == 0) {
        if (n_in != 19 || out_size != MT * DM || ws_size < WS_END) { fprintf(stderr, "kernel_launch: unexpected shapes (n_in %d out %d ws %zu)\n", n_in, out_size, ws_size); grid = -1; return; }
        int dev = 0, cus = 0, per_cu = 0;
        hipGetDevice(&dev);
        hipDeviceGetAttribute(&cus, hipDeviceAttributeMultiprocessorCount, dev);
        hipFuncSetAttribute((const void*)fwd, hipFuncAttributeMaxDynamicSharedMemorySize, LDS_BYTES);
        hipOccupancyMaxActiveBlocksPerMultiprocessor(&per_cu, (const void*)fwd, 512, LDS_BYTES);
        if (per_cu < 1) { fprintf(stderr, "kernel_launch: occupancy query says %d blocks/CU\n", per_cu); per_cu = 1; }
        grid = cus * per_cu;
    }
    if (grid < 0) return;
    if (hipMemsetAsync((char*)d_ws + WS_BAR, 0, 16384, stream) != hipSuccess) { fprintf(stderr, "kernel_launch: memset failed\n"); return; }
    Params p{};
    for (int i = 0; i < 19; ++i) p.in[i] = (const float*)d_in[i];
    p.out = (float*)d_out; p.ws = (unsigned char*)d_ws; p.ph_lo = 0;
#ifdef DBG_HI
    p.ph_hi = DBG_HI;
#else
    p.ph_hi = 11;
#endif
    void* args[] = {&p};
    hipError_t e = hipLaunchCooperativeKernel((const void*)fwd, dim3(grid), dim3(512), args, LDS_BYTES, stream);
    if (e != hipSuccess) fprintf(stderr, "cooperative launch failed: %s (grid %d)\n", hipGetErrorString(e), grid);
}
```

```cpp
#include <hip/hip_runtime.h>
#include <hip/hip_cooperative_groups.h>
#include <cstdio>
#include <cstdint>
namespace cg = cooperative_groups;

#define LAS __attribute__((address_space(3)))
#define GAS __attribute__((address_space(1)))
typedef unsigned short bf16_t;
typedef short bf16x8 __attribute__((ext_vector_type(8)));
typedef float f32x4 __attribute__((ext_vector_type(4)));
typedef unsigned u32x4 __attribute__((ext_vector_type(4)));
typedef unsigned u32x2 __attribute__((ext_vector_type(2)));

__device__ __forceinline__ unsigned f2bf(float f) { unsigned u = __builtin_bit_cast(unsigned, f); return (u + 0x7fffu + ((u >> 16) & 1u)) >> 16; }
typedef __bf16 bf16x2_t __attribute__((ext_vector_type(2)));
typedef float f32x2_t __attribute__((ext_vector_type(2)));
__device__ __forceinline__ unsigned cvt_pk(float lo, float hi) { const f32x2_t v = {lo, hi}; const bf16x2_t b = __builtin_convertvector(v, bf16x2_t); return __builtin_bit_cast(unsigned, b); }
__device__ __forceinline__ float bflo(unsigned w) { return __builtin_bit_cast(float, w << 16); }
__device__ __forceinline__ float bfhi(unsigned w) { return __builtin_bit_cast(float, w & 0xffff0000u); }
__device__ __forceinline__ float bf2f(bf16_t b) { return __builtin_bit_cast(float, (unsigned)b << 16); }
__device__ __forceinline__ float wave_sum(float v) {
#pragma unroll
    for (int o = 1; o < 64; o <<= 1) v += __shfl_xor(v, o);
    return v;
}
#define MFMA16(a, b, c) __builtin_amdgcn_mfma_f32_16x16x32_bf16((a), (b), (c), 0, 0, 0)

namespace pg8 {
constexpr int BM = 256, BK = 64, HALF = 128, HTB = HALF * BK * 2, STAGE_BYTES = 8 * HTB, NXCD = 8, WGM = 8;
__host__ __device__ __forceinline__ int lds_byte(int r, int c) { const int st = (r >> 4) * 2 + (c >> 5), rr = r & 15, cc = c & 31, ob = rr * 64 + cc * 2; return st * 1024 + (ob ^ (((ob >> 9) & 1) << 5)); }
__host__ __device__ __forceinline__ void stage_rc(int b, int& R, int& C) { const int st = b / 1024, sb = b % 1024, swz = sb ^ (((sb >> 9) & 1) << 5); R = (st >> 1) * 16 + swz / 64; C = (st & 1) * 32 + (swz % 64) / 2; }
__host__ __device__ __forceinline__ int perm32(int rho) { const int n = rho >> 4, i = rho & 15; return 8 * (i >> 2) + 4 * n + (i & 3); }
struct Unit { int pm, pn; };
struct Gemm { const bf16_t* A; const bf16_t* Bt; int M, N, K, lda; };
struct StaticOrder {
    int nM, nN, nwg, G, c;
    __device__ void init(int M, int N, int G_, int c_) { nM = M / BM; nN = N / BM; nwg = nM * nN; G = G_; c = c_; }
    __device__ bool next(int i, Unit& u) const {
        const long L = (long)i * G + c; if (L >= nwg) return false;
        int wgid = (int)L; { const int q = nwg / NXCD, r = nwg % NXCD, xcd = wgid % NXCD, off = wgid / NXCD; wgid = (xcd < r ? xcd * (q + 1) : r * (q + 1) + (xcd - r) * q) + off; }
        const int nig = WGM * nN, gid = wgid / nig, fm = gid * WGM, gsz = (nM - fm) < WGM ? (nM - fm) : WGM;
        u.pm = fm + ((wgid % nig) % gsz); u.pn = (wgid % nig) / gsz; return true;
    }
};

template <class Epi, bool ALIGN_EPI>
__device__ __forceinline__ void gemm_phase(LAS unsigned char* lds, const Gemm g, const StaticOrder& S, const Epi& E) {
    const int tid = threadIdx.x, wid = __builtin_amdgcn_readfirstlane(tid >> 6), lane = tid & 63, wr = wid >> 2, wc = wid & 3, fr = lane & 15, fq = lane >> 4;
    const int K = g.K, nt = K / BK, lda = g.lda;
    unsigned voffA[2], voffB[2];
#pragma unroll
    for (int i = 0; i < 2; ++i) { int R, C; stage_rc(tid * 16 + i * 8192, R, C); const int Rb = Epi::PERM ? ((R & ~31) + perm32(R & 31)) : R;
        voffA[i] = (unsigned)(R * lda + C) * 2u; voffB[i] = (unsigned)(Rb * K + C) * 2u; }
    const size_t kstep = (size_t)(BK * 2);
    const size_t hstepA = (size_t)HALF * lda * 2, hstepB = (size_t)HALF * K * 2;
    const size_t tstepA = 2 * hstepA, tstepB = 2 * hstepB;
    const unsigned ldsw = (unsigned)wid * 1024u;
    const int aoff = lds_byte(wr * 64 + fr, fq * 8), boff = lds_byte(wc * 32 + fr, fq * 8);
#define PG8_SA(b, h) (((b) * 2 + (h)) * HTB)
#define PG8_SB(b, h) ((4 + (b) * 2 + (h)) * HTB)
#define PG8_STAGE(bufoff, gbase, voff) do { _Pragma("unroll") for (int _i = 0; _i < 2; ++_i) \
        __builtin_amdgcn_global_load_lds((const unsigned*)((const char*)(gbase) + (voff)[_i]), (LAS unsigned*)(lds + (bufoff) + ldsw + _i * 8192), 16, 0, 0); } while (0)
#define PG8_LDA(dst, b, h) do { _Pragma("unroll") for (int m = 0; m < 4; ++m) _Pragma("unroll") for (int k = 0; k < 2; ++k) dst[m][k] = *(const LAS bf16x8*)(lds + PG8_SA(b, h) + aoff + m * 2048 + k * 1024); } while (0)
#define PG8_LDB(dst, b, h) do { _Pragma("unroll") for (int n = 0; n < 2; ++n) _Pragma("unroll") for (int k = 0; k < 2; ++k) dst[n][k] = *(const LAS bf16x8*)(lds + PG8_SB(b, h) + boff + n * 2048 + k * 1024); } while (0)
#define PG8_MMA(ai, bj, At, Bt) do { __builtin_amdgcn_s_setprio(1); _Pragma("unroll") for (int m = 0; m < 4; ++m) _Pragma("unroll") for (int n = 0; n < 2; ++n) _Pragma("unroll") for (int k = 0; k < 2; ++k) \
        acc[ai][bj][m][n] = __builtin_amdgcn_mfma_f32_16x16x32_bf16(Bt[n][k], At[m][k], acc[ai][bj][m][n], 0, 0, 0); __builtin_amdgcn_s_setprio(0); } while (0)
#define PG8_WAIT_V(n) asm volatile("s_waitcnt vmcnt(" #n ")" ::: "memory")
#define PG8_WAIT_L(n) asm volatile("s_waitcnt lgkmcnt(" #n ")" ::: "memory")
#define PG8_BAR __builtin_amdgcn_s_barrier()
#define PG8_SCHED __builtin_amdgcn_sched_barrier(0)
    Unit cur, nxt; int ui = 0;
    if (!S.next(0, cur)) return;
    f32x4 acc[2][2][4][2];
#pragma unroll
    for (int a = 0; a < 2; ++a)
#pragma unroll
        for (int b = 0; b < 2; ++b)
#pragma unroll
            for (int m = 0; m < 4; ++m)
#pragma unroll
                for (int n = 0; n < 2; ++n) acc[a][b][m][n] = (f32x4){0.f, 0.f, 0.f, 0.f};
    bf16x8 At[4][2], B0[2][2], B1[2][2];
    const char* cA = (const char*)g.A + (size_t)cur.pm * tstepA; const char* cB = (const char*)g.Bt + (size_t)cur.pn * tstepB;
    PG8_STAGE(PG8_SB(0, 0), cB, voffB); PG8_STAGE(PG8_SB(0, 1), cB + hstepB, voffB); PG8_STAGE(PG8_SA(0, 0), cA, voffA); PG8_STAGE(PG8_SA(0, 1), cA + hstepA, voffA);
    if (wr == 1) PG8_BAR;
    PG8_WAIT_V(2); PG8_BAR;
    PG8_STAGE(PG8_SB(1, 0), cB + kstep, voffB); PG8_STAGE(PG8_SA(1, 0), cA + kstep, voffA); PG8_STAGE(PG8_SB(1, 1), cB + hstepB + kstep, voffB);
    PG8_WAIT_V(6); PG8_BAR;
    for (;;) {
        const bool has_next = S.next(ui + 1, nxt);
        const char* nA = has_next ? (const char*)g.A + (size_t)nxt.pm * tstepA : cA; const char* nB = has_next ? (const char*)g.Bt + (size_t)nxt.pn * tstepB : cB;
        for (int t = 0; t < nt; t += 2) {
            const bool last = (t == nt - 2);
            const char* a1 = cA + (size_t)(t + 1) * kstep;
            const char* a2 = last ? nA : cA + (size_t)(t + 2) * kstep; const char* b2 = last ? nB : cB + (size_t)(t + 2) * kstep;
            const char* a3 = a2 + kstep; const char* b3 = b2 + kstep;
            PG8_LDB(B0, 0, 0); PG8_LDB(B1, 0, 1); PG8_SCHED; PG8_LDA(At, 0, 0); PG8_STAGE(PG8_SA(1, 1), a1 + hstepA, voffA);
            PG8_WAIT_V(8); PG8_WAIT_L(0); PG8_BAR; PG8_MMA(0, 0, At, B0); PG8_MMA(0, 1, At, B1); PG8_BAR; PG8_SCHED;
            PG8_LDA(At, 0, 1); PG8_STAGE(PG8_SB(0, 0), b2, voffB); PG8_STAGE(PG8_SB(0, 1), b2 + hstepB, voffB); PG8_STAGE(PG8_SA(0, 0), a2, voffA);
            PG8_WAIT_V(8); PG8_WAIT_L(0); PG8_BAR; PG8_MMA(1, 0, At, B0); PG8_MMA(1, 1, At, B1); PG8_BAR; PG8_SCHED;
            PG8_LDB(B0, 1, 0); PG8_LDB(B1, 1, 1); PG8_SCHED; PG8_LDA(At, 1, 0); PG8_STAGE(PG8_SA(0, 1), a2 + hstepA, voffA);
            PG8_WAIT_V(8); PG8_WAIT_L(0); PG8_BAR; PG8_MMA(0, 0, At, B0); PG8_MMA(0, 1, At, B1); PG8_BAR; PG8_SCHED;
            PG8_LDA(At, 1, 1); PG8_STAGE(PG8_SB(1, 0), b3, voffB); PG8_STAGE(PG8_SB(1, 1), b3 + hstepB, voffB); PG8_STAGE(PG8_SA(1, 0), a3, voffA);
            PG8_WAIT_V(8); PG8_WAIT_L(0); PG8_BAR; PG8_MMA(1, 0, At, B0); PG8_MMA(1, 1, At, B1); PG8_BAR; PG8_SCHED;
        }
        if constexpr (ALIGN_EPI) { if (wr == 0) PG8_BAR; }
        E(acc, cur, wr, wc, fr, fq);
        if (!has_next) break;
#pragma unroll
        for (int a = 0; a < 2; ++a)
#pragma unroll
            for (int b = 0; b < 2; ++b)
#pragma unroll
                for (int m = 0; m < 4; ++m)
#pragma unroll
                    for (int n = 0; n < 2; ++n) acc[a][b][m][n] = (f32x4){0.f, 0.f, 0.f, 0.f};
        cur = nxt; cA = nA; cB = nB; ++ui;
        if constexpr (ALIGN_EPI) { if (wr == 1) PG8_BAR; }
    }
    PG8_WAIT_V(0);
    if constexpr (!ALIGN_EPI) { if (wr == 0) PG8_BAR; }
    PG8_BAR;
#undef PG8_SA
#undef PG8_SB
#undef PG8_STAGE
#undef PG8_LDA
#undef PG8_LDB
#undef PG8_MMA
#undef PG8_WAIT_V
#undef PG8_WAIT_L
#undef PG8_BAR
#undef PG8_SCHED
}
}

constexpr int NB = 4, SEQ = 4096, DM = 1024, MT = NB * SEQ, DIN = 5648, DFF = 2816;
constexpr size_t MiB = 1u << 20;
constexpr size_t WS_MODP = 0;
constexpr size_t WS_MOD = 1536 * 1024;
constexpr size_t WS_CDEC = WS_MOD + 98304;
constexpr size_t WS_BAR = 1792 * 1024;
constexpr size_t WS_WIN = 2 * MiB;
constexpr size_t WS_WOUT = 13 * MiB;
constexpr size_t WS_WGU = 17 * MiB;
constexpr size_t WS_WDN = 28 * MiB;
constexpr size_t WS_DT = 34 * MiB;
constexpr size_t WS_H = 35 * MiB;
constexpr size_t WS_PROJ = 67 * MiB;
constexpr size_t WS_VT = 163 * MiB;
constexpr size_t WS_XBC = 195 * MiB;
constexpr size_t WS_END = 243 * MiB;
constexpr size_t WS_ACT = WS_PROJ;
constexpr size_t WS_ST = WS_XBC;
constexpr int LDS_BYTES = 147456;

struct Params { const float* in[19]; float* out; unsigned char* ws; int ph_lo, ph_hi; };


#define XB_TMO      128
#define XB_XCNT(j)  (256  + 64 * (j))
#define XB_XSUB(j)  (1280 + 64 * (j))
#define XB_XGEN(j)  (2304 + 64 * (j))
#define XB_TOP      3328
#define XB_TOPGEN   3392
#define XCD_BAR_WORDS 3456
#define XB_SPIN_CAP (1u << 18)
__device__ __forceinline__ unsigned xb_ld(unsigned* p)              { return __hip_atomic_load(p, __ATOMIC_RELAXED, __HIP_MEMORY_SCOPE_AGENT); }
__device__ __forceinline__ unsigned xb_add(unsigned* p, unsigned v) { return __hip_atomic_fetch_add(p, v, __ATOMIC_RELAXED, __HIP_MEMORY_SCOPE_AGENT); }
__device__ __forceinline__ unsigned xb_xcc_id() { return (unsigned)__builtin_amdgcn_s_getreg((3 << 11) | 20) & 0xFu; }
#define XB_SPIN(cond, bar) do { unsigned _sp = 0; while (cond) { __builtin_amdgcn_s_sleep(1); \
    if ((++_sp & 255u) == 0u) { if (xb_ld(&(bar)[XB_TMO])) break; if (_sp > XB_SPIN_CAP) { atomicAdd(&(bar)[XB_TMO], 1u); break; } } } } while (0)
__device__ __forceinline__ void xcd_barrier_complete(unsigned* bar, unsigned x, unsigned& nloc, unsigned& nx) {
    const unsigned G = gridDim.x * gridDim.y * gridDim.z;
    unsigned sum, cnt, mine, sp = 0u;
    for (;;) {
        sum = 0u; cnt = 0u; mine = 0u;
#pragma unroll
        for (unsigned j = 0; j < 16; ++j) { const unsigned c = xb_ld(&bar[XB_XCNT(j)]); sum += c; cnt += (c > 0u) ? 1u : 0u; mine = (j == x) ? c : mine; }
        if (sum == G) break;
        __builtin_amdgcn_s_sleep(1);
        if ((++sp & 255u) == 0u) { if (xb_ld(&bar[XB_TMO])) break; if (sp > XB_SPIN_CAP) { atomicAdd(&bar[XB_TMO], 1u); break; } }
    }
    nloc = mine > 0u ? mine : 1u; nx = cnt > 0u ? cnt : 1u;
}
__device__ __forceinline__ void xcd_barrier(unsigned* bar, volatile LAS unsigned* st) {
    asm volatile("s_waitcnt vmcnt(0)" ::: "memory");
    __syncthreads();
    if (threadIdx.x == 0) {
        const unsigned x = xb_xcc_id();
        __builtin_amdgcn_s_waitcnt(0);
        unsigned nloc = st[0], nx = st[1];
        if (nloc == 0u) { xcd_barrier_complete(bar, x, nloc, nx); st[0] = nloc; st[1] = nx; }
        const unsigned old = xb_add(&bar[XB_XSUB(x)], 1u);
        const unsigned gen = old / nloc;
        if (old + 1u == (gen + 1u) * nloc) {
            __builtin_amdgcn_fence(__ATOMIC_RELEASE, "agent");
            asm volatile("s_waitcnt vmcnt(0)" ::: "memory");
            const unsigned og = xb_add(&bar[XB_TOP], 1u);
            const unsigned tg = og / nx;
            if (og + 1u == (tg + 1u) * nx) xb_add(&bar[XB_TOPGEN], 1u);
            else XB_SPIN(xb_ld(&bar[XB_TOPGEN]) == tg, bar);
            __builtin_amdgcn_fence(__ATOMIC_ACQUIRE, "agent");
            xb_add(&bar[XB_XGEN(x)], 1u);
            asm volatile("s_waitcnt vmcnt(0)" ::: "memory");
        } else {
            XB_SPIN(xb_ld(&bar[XB_XGEN(x)]) == gen, bar);
            __builtin_amdgcn_fence(__ATOMIC_ACQUIRE, "agent");
            asm volatile("s_waitcnt vmcnt(0)" ::: "memory");
        }
    }
    __syncthreads();
}

struct EpiProj {
    static constexpr bool PERM = true;
    GAS bf16_t* P; GAS bf16_t* X; const GAS float* qnw; const GAS float* knw; GAS bf16_t* KF;
    __device__ __forceinline__ void operator()(const f32x4 (&acc)[2][2][4][2], const pg8::Unit& u, int wr, int wc, int fr, int fq) const {
        const int row0 = u.pm * 256 + wr * 64 + fr;
        if (u.pn >= 4 && u.pn < 12) {
            const bool isq = u.pn < 8; const GAS float* nw = isq ? qnw : knw; const float sc = isq ? 0.125f * 1.44269504089f : 1.f;
            const int colb = (isq ? 1024 : 2048) + 64 * (4 * (u.pn & 3) + wc) + 8 * fq;
            f32x4 w4[2][2];
#pragma unroll
            for (int bj = 0; bj < 2; ++bj)
#pragma unroll
                for (int n = 0; n < 2; ++n) w4[bj][n] = *(const GAS f32x4*)(nw + 32 * bj + 8 * fq + 4 * n) * sc;
#pragma unroll
            for (int ai = 0; ai < 2; ++ai)
#pragma unroll
                for (int m = 0; m < 4; ++m) { float ss = 0.f;
#pragma unroll
                    for (int bj = 0; bj < 2; ++bj)
#pragma unroll
                        for (int n = 0; n < 2; ++n) { const f32x4 v = acc[ai][bj][m][n]; ss += (v[0] * v[0] + v[1] * v[1]) + (v[2] * v[2] + v[3] * v[3]); }
                    ss += __shfl_xor(ss, 16); ss += __shfl_xor(ss, 32);
                    const float rstd = 1.0f / sqrtf(ss * (1.f / 64.f) + 1e-6f);
                    const int row = row0 + ai * 128 + m * 16;
                    GAS bf16_t* rowp = P + (size_t)row * 3072 + colb;
                    GAS bf16_t* kfp = KF + ((((size_t)((row >> 12) * 16 + 4 * (u.pn & 3) + wc) * 256 + ((row & 4095) >> 4)) * 2) * 64 + fq * 16 + fr) * 8;
#pragma unroll
                    for (int bj = 0; bj < 2; ++bj) { const f32x4 v0 = acc[ai][bj][m][0] * rstd * w4[bj][0], v1 = acc[ai][bj][m][1] * rstd * w4[bj][1];
                        u32x4 w; w.x = cvt_pk(v0[0], v0[1]); w.y = cvt_pk(v0[2], v0[3]); w.z = cvt_pk(v1[0], v1[1]); w.w = cvt_pk(v1[2], v1[3]);
                        if (isq) *(GAS u32x4*)(rowp + bj * 32) = w; else *(GAS u32x4*)(kfp + bj * 512) = w; } }
            return;
        }
        GAS bf16_t* base; int ldc, colt;
        if (u.pn < 12) { base = P; ldc = 3072; colt = u.pn * 256; } else { base = X; ldc = 1536; colt = (u.pn - 12) * 256; }
        const int col0 = colt + wc * 32 + 8 * fq;
#pragma unroll
        for (int ai = 0; ai < 2; ++ai)
#pragma unroll
            for (int m = 0; m < 4; ++m) { GAS bf16_t* rowp = base + (size_t)(row0 + ai * 128 + m * 16) * ldc + col0;
#pragma unroll
                for (int bj = 0; bj < 2; ++bj) { const f32x4 v0 = acc[ai][bj][m][0], v1 = acc[ai][bj][m][1];
                    u32x4 w; w.x = cvt_pk(v0[0], v0[1]); w.y = cvt_pk(v0[2], v0[3]); w.z = cvt_pk(v1[0], v1[1]); w.w = cvt_pk(v1[2], v1[3]);
                    *(GAS u32x4*)(rowp + bj * 128) = w; } }
    }
};
struct EpiVT {
    static constexpr bool PERM = true;
    GAS bf16_t* VT;
    __device__ __forceinline__ void operator()(const f32x4 (&acc)[2][2][4][2], const pg8::Unit& u, int wr, int wc, int fr, int fq) const {
        const int b = u.pn >> 4, row0 = u.pm * 256 + wr * 64 + fr, qa = 2 * (fq & 1), hi = fq >> 1;
#pragma unroll
        for (int ai = 0; ai < 2; ++ai)
#pragma unroll
            for (int m = 0; m < 4; ++m) { const int c = row0 + ai * 128 + m * 16;
#pragma unroll
                for (int bj = 0; bj < 2; ++bj) { const f32x4 v0 = acc[ai][bj][m][0], v1 = acc[ai][bj][m][1];
                    const int tg = (u.pn & 15) * 8 + wc + bj * 4;
                    GAS bf16_t* vp = VT + (((((size_t)(b * 16 + (c >> 6)) * 128 + tg) * 4 + ((c >> 4) & 3)) * 64) + qa * 16 + fr) * 8 + 4 * hi;
                    u32x2 wa, wb; wa.x = cvt_pk(v0[0], v0[1]); wa.y = cvt_pk(v0[2], v0[3]); wb.x = cvt_pk(v1[0], v1[1]); wb.y = cvt_pk(v1[2], v1[3]);
                    *(GAS u32x2*)vp = wa; *(GAS u32x2*)(vp + 128) = wb; } }
    }
};
struct EpiRes {
    static constexpr bool PERM = false;
    const GAS float* X; GAS float* O; const GAS float* gate;
    __device__ __forceinline__ void operator()(const f32x4 (&acc)[2][2][4][2], const pg8::Unit& u, int wr, int wc, int fr, int fq) const {
        const int b = u.pm >> 4, col0 = u.pn * 256 + wc * 32 + 4 * fq, row0 = u.pm * 256 + wr * 64 + fr;
        f32x4 gv[2][2];
#pragma unroll
        for (int bj = 0; bj < 2; ++bj)
#pragma unroll
            for (int n = 0; n < 2; ++n) gv[bj][n] = *(const GAS f32x4*)(gate + b * 6144 + col0 + bj * 128 + 16 * n);
#pragma unroll
        for (int ai = 0; ai < 2; ++ai)
#pragma unroll
            for (int m = 0; m < 4; ++m) { const size_t ro = (size_t)(row0 + ai * 128 + m * 16) * 1024 + col0;
#pragma unroll
                for (int bj = 0; bj < 2; ++bj)
#pragma unroll
                    for (int n = 0; n < 2; ++n) { const size_t idx = ro + bj * 128 + 16 * n; const f32x4 xv = *(const GAS f32x4*)(X + idx);
                        *(GAS f32x4*)(O + idx) = xv + gv[bj][n] * acc[ai][bj][m][n]; } }
    }
};
struct EpiGU {
    static constexpr bool PERM = true;
    GAS bf16_t* ACT;
    __device__ __forceinline__ void operator()(const f32x4 (&acc)[2][2][4][2], const pg8::Unit& u, int wr, int wc, int fr, int fq) const {
        const int col0 = u.pn * 128 + wc * 32 + 8 * fq, row0 = u.pm * 256 + wr * 64 + fr;
#pragma unroll
        for (int ai = 0; ai < 2; ++ai)
#pragma unroll
            for (int m = 0; m < 4; ++m) {
                float r[8];
#pragma unroll
                for (int n = 0; n < 2; ++n)
#pragma unroll
                    for (int e = 0; e < 4; ++e) { const float gt = acc[ai][0][m][n][e], up = acc[ai][1][m][n][e]; r[4 * n + e] = gt * __builtin_amdgcn_rcpf(1.f + __expf(-gt)) * up; }
                u32x4 w; w.x = cvt_pk(r[0], r[1]); w.y = cvt_pk(r[2], r[3]); w.z = cvt_pk(r[4], r[5]); w.w = cvt_pk(r[6], r[7]);
                *(GAS u32x4*)(ACT + (size_t)(row0 + ai * 128 + m * 16) * DFF + col0) = w; }
    }
};

template <int MODE> __device__ __forceinline__ int dest_row(int n) {
    if (MODE == 0) { if (n < 1024) return n; if (n < 2560) return 3072 + (n - 1024); if (n < 2576) return -1;
        if (n < 4624) { const int c = n - 2576, base = c < 1024 ? 1024 : 2048, cc = c & 1023, hh = cc >> 6, d = cc & 63;
            return base + 256 * (hh >> 2) + 128 * (d >> 5) + 32 * (hh & 3) + (d & 31); }
        return 4608 + (n - 4624); }
    if (MODE == 1) return n;
    if (MODE == 2) return 256 * (n >> 7) + (n & 127);
    return 256 * (n >> 7) + 128 + (n & 127);
}
template <int MODE> __device__ __forceinline__ void transpose_item(const float* W, int K, int N, bf16_t* WT, LAS float* scr, int item, int lane) {
    const int nblk = (N + 31) / 32, kb = item / nblk, nb = item % nblk, k0 = 64 * kb, n0 = 32 * nb;
    const int nn = n0 + (lane & 31); const bool ok = nn < N;
#pragma unroll
    for (int i = 0; i < 32; ++i) { const int kk = 2 * i + (lane >> 5); scr[kk * 33 + (lane & 31)] = ok ? __builtin_nontemporal_load((const GAS float*)W + (size_t)(k0 + kk) * N + nn) : 0.f; }
    asm volatile("s_waitcnt lgkmcnt(0)" ::: "memory");
    const int c = lane & 7;
#pragma unroll
    for (int j = 0; j < 4; ++j) { const int n = (lane >> 3) + 8 * j; const LAS float* s = scr + (8 * c) * 33 + n;
        const int dr = (n0 + n < N) ? dest_row<MODE>(n0 + n) : -1;
        u32x4 o; o.x = cvt_pk(s[0 * 33], s[1 * 33]); o.y = cvt_pk(s[2 * 33], s[3 * 33]); o.z = cvt_pk(s[4 * 33], s[5 * 33]); o.w = cvt_pk(s[6 * 33], s[7 * 33]);
        if (dr >= 0) *(u32x4*)(WT + (size_t)dr * K + k0 + 8 * c) = o; }
    asm volatile("s_waitcnt lgkmcnt(0)" ::: "memory");
}

__device__ __forceinline__ void chunk_cumsum(float v0, float v1, int lane, float& s0, float& s1) {
    s0 = v0; s1 = v1;
#pragma unroll
    for (int o = 1; o < 64; o <<= 1) { const float t0 = __shfl_up(s0, o), t1 = __shfl_up(s1, o); if (lane >= o) { s0 += t0; s1 += t1; } }
    s1 += __shfl(s0, 63);
}

__global__ void __launch_bounds__(512, 2) fwd(Params p) {
    extern __shared__ __attribute__((aligned(16))) unsigned char lds_raw[];
    LAS unsigned char* lds = (LAS unsigned char*)lds_raw;
    cg::grid_group grid = cg::this_grid();
    const int lo = p.ph_lo, hi = p.ph_hi;
    if (hi > 1000) grid.sync();
    if (threadIdx.x < 2) ((volatile LAS unsigned*)(lds + 131072))[threadIdx.x] = 0u;
    if (threadIdx.x == 0) (void)xb_add((unsigned*)(p.ws + WS_BAR) + XB_XCNT(xb_xcc_id()), 1u);
    __syncthreads();
#define PHASE_VARS \
    int tid = threadIdx.x; asm volatile("" : "+v"(tid)); \
    const int lane = tid & 63, wave = __builtin_amdgcn_readfirstlane(tid >> 6), fr = lane & 15, fq = lane >> 4; \
    int G = gridDim.x; asm volatile("" : "+s"(G)); \
    const int gw = blockIdx.x * 8 + wave, NGW = G * 8; \
    unsigned char* ws = p.ws; asm volatile("" : "+s"(ws)); \
    float* out = p.out; asm volatile("" : "+s"(out)); \
    (void)lane; (void)wave; (void)fr; (void)fq; (void)gw; (void)NGW; (void)ws; (void)out;
#define P_MODP ((float*)(ws + WS_MODP))
#define P_MOD ((float*)(ws + WS_MOD))
#define P_CDEC ((float*)(ws + WS_CDEC))
#define P_WIN ((bf16_t*)(ws + WS_WIN))
#define P_WOUT ((bf16_t*)(ws + WS_WOUT))
#define P_WGU ((bf16_t*)(ws + WS_WGU))
#define P_WDN ((bf16_t*)(ws + WS_WDN))
#define P_DT ((float*)(ws + WS_DT))
#define P_HB ((bf16_t*)(ws + WS_H))
#define P_PROJ ((bf16_t*)(ws + WS_PROJ))
#define P_VT ((bf16_t*)(ws + WS_VT))
#define P_XBC ((bf16_t*)(ws + WS_XBC))
#define P_ST ((bf16_t*)(ws + WS_ST))
#define P_ACT ((bf16_t*)(ws + WS_ACT))
#define P_XC ((bf16_t*)out)
#define P_BC ((bf16_t*)((unsigned char*)out + 32 * MiB))
#define P_BT ((bf16_t*)((unsigned char*)out + 48 * MiB))
#define IN(k) (lo <= (k) && (k) < hi)
#define GRID_BAR() xcd_barrier((unsigned*)(p.ws + WS_BAR), (volatile LAS unsigned*)(lds + 131072))
#define SEAM(k) do { if (IN(k) && IN((k) + 1)) GRID_BAR(); } while (0)

    if (IN(0)) {
        PHASE_VARS
        LAS float* cond = (LAS float*)(lds + 70000 / 16 * 16);
        for (int it = blockIdx.x; it < 192; it += G) {
            const int kc = it / 12, cb = it % 12, j = cb * 512 + tid;
            __syncthreads();
            if (tid < 256) { const int b = tid >> 6, k = kc * 64 + (tid & 63); const float cv = (p.in[1])[b * 1024 + k]; cond[tid] = cv / (1.f + expf(-cv)); }
            __syncthreads();
            float a0 = 0.f, a1 = 0.f, a2 = 0.f, a3 = 0.f;
#pragma unroll 16
            for (int k = 0; k < 64; ++k) { const float w = __builtin_nontemporal_load((const GAS float*)(p.in[2]) + (size_t)(kc * 64 + k) * 6144 + j); a0 += cond[k] * w; a1 += cond[64 + k] * w; a2 += cond[128 + k] * w; a3 += cond[192 + k] * w; }
            P_MODP[(kc * 4 + 0) * 6144 + j] = a0; P_MODP[(kc * 4 + 1) * 6144 + j] = a1; P_MODP[(kc * 4 + 2) * 6144 + j] = a2; P_MODP[(kc * 4 + 3) * 6144 + j] = a3;
        }
        LAS float* scr = (LAS float*)lds + wave * (64 * 33);
        constexpr int I_IN = 16 * 177, I_OUT = 32 * 32, I_G = 16 * 88, I_DN = 44 * 32;
        for (int it = gw; it < I_IN + I_OUT + 2 * I_G + I_DN; it += NGW) {
            int r = it;
            if (r < I_IN) { transpose_item<0>((p.in[5]), 1024, DIN, P_WIN, scr, r, lane); continue; } r -= I_IN;
            if (r < I_OUT) { transpose_item<1>((p.in[14]), 2048, 1024, P_WOUT, scr, r, lane); continue; } r -= I_OUT;
            if (r < I_G) { transpose_item<2>((p.in[16]), 1024, DFF, P_WGU, scr, r, lane); continue; } r -= I_G;
            if (r < I_G) { transpose_item<3>((p.in[17]), 1024, DFF, P_WGU, scr, r, lane); continue; } r -= I_G;
            transpose_item<1>((p.in[18]), DFF, 1024, P_WDN, scr, r, lane);
        }
    }
    SEAM(0);

    if (IN(1)) {
        PHASE_VARS
        LAS float* wdt = (LAS float*)lds; LAS float* scl = wdt + 16384; LAS float* shf = scl + 1024;
        __syncthreads();
        for (int i = tid; i < 16384; i += 512) { const int k = i >> 4, ii = i & 15; wdt[ii * 1024 + k] = ((const GAS float*)(p.in[5]))[(size_t)k * DIN + 2560 + ii]; }
        for (int i = blockIdx.x * 512 + tid; i < 24576; i += G * 512) { float s = (p.in[3])[i % 6144];
#pragma unroll
            for (int kc = 0; kc < 16; ++kc) s += P_MODP[kc * 24576 + i];
            P_MOD[i] = s; }
        for (int rb = blockIdx.x; rb < 256; rb += G) {
            const int b = rb >> 6;
            __syncthreads();
            for (int k = tid; k < 1024; k += 512) { float sh = (p.in[3])[k], sc = (p.in[3])[1024 + k];
#pragma unroll
                for (int kc = 0; kc < 16; ++kc) { sh += P_MODP[(kc * 4 + b) * 6144 + k]; sc += P_MODP[(kc * 4 + b) * 6144 + 1024 + k]; }
                scl[k] = (p.in[4])[k] * (1.f + sc); shf[k] = sh; }
            __syncthreads();
            f32x4 vnx[2][4];
#pragma unroll
            for (int q = 0; q < 2; ++q)
#pragma unroll
                for (int j = 0; j < 4; ++j) vnx[q][j] = __builtin_nontemporal_load((const GAS f32x4*)((const GAS float*)p.in[0] + (size_t)(rb * 64 + wave + 8 * q) * 1024 + 4 * lane + 256 * j));
            for (int r = wave; r < 64; r += 16) {
                const int row0_ = rb * 64 + r;
                f32x4 v[2][4]; float ss[2] = {0.f, 0.f};
#pragma unroll
                for (int q = 0; q < 2; ++q)
#pragma unroll
                    for (int j = 0; j < 4; ++j) { v[q][j] = vnx[q][j];
                        ss[q] += (v[q][j].x * v[q][j].x + v[q][j].y * v[q][j].y) + (v[q][j].z * v[q][j].z + v[q][j].w * v[q][j].w); }
                { const int rn = r + 16 < 64 ? r + 16 : r;
#pragma unroll
                  for (int q = 0; q < 2; ++q)
#pragma unroll
                    for (int j = 0; j < 4; ++j) vnx[q][j] = __builtin_nontemporal_load((const GAS f32x4*)((const GAS float*)p.in[0] + (size_t)(rb * 64 + rn + 8 * q) * 1024 + 4 * lane + 256 * j)); }
                __builtin_amdgcn_sched_barrier(0);
#pragma unroll
                for (int q = 0; q < 2; ++q) {
                    const int row = row0_ + 8 * q;
                    const float rstd = 1.0f / sqrtf(wave_sum(ss[q]) * (1.f / 1024.f) + 1e-6f);
#pragma unroll
                    for (int j = 0; j < 4; ++j) { const int k = 4 * lane + 256 * j; const f32x4 s4 = *(const LAS f32x4*)(scl + k), t4 = *(const LAS f32x4*)(shf + k);
                        v[q][j] = v[q][j] * rstd * s4 + t4;
                        u32x2 w; w.x = cvt_pk(v[q][j].x, v[q][j].y); w.y = cvt_pk(v[q][j].z, v[q][j].w);
                        *(GAS u32x2*)((GAS bf16_t*)P_HB + (size_t)row * 1024 + k) = w; }
                }
                float pa[16], pb[16];
#pragma unroll
                for (int ii = 0; ii < 16; ++ii) { float a0 = 0.f, a1 = 0.f;
#pragma unroll
                    for (int j = 0; j < 4; ++j) { const f32x4 w4 = *(const LAS f32x4*)(wdt + ii * 1024 + 4 * lane + 256 * j);
                        a0 += (v[0][j].x * w4.x + v[0][j].y * w4.y) + (v[0][j].z * w4.z + v[0][j].w * w4.w);
                        a1 += (v[1][j].x * w4.x + v[1][j].y * w4.y) + (v[1][j].z * w4.z + v[1][j].w * w4.w); }
                    pa[ii] = a0; pb[ii] = a1; }
                const int oi = ((lane >> 5) & 1) * 8 + ((lane >> 4) & 1) * 4 + ((lane >> 3) & 1) * 2 + ((lane >> 2) & 1);
                const float dtb = (p.in[8])[oi];
#pragma unroll
                for (int st = 0; st < 4; ++st) { const int msk = 32 >> st, cnt = 8 >> st; const bool up = (lane & msk) != 0;
#pragma unroll
                    for (int i = 0; i < 8; ++i) if (i < cnt) {
                        { const float keep = up ? pa[i + cnt] : pa[i], send = up ? pa[i] : pa[i + cnt]; pa[i] = keep + __shfl_xor(send, msk); }
                        { const float keep = up ? pb[i + cnt] : pb[i], send = up ? pb[i] : pb[i + cnt]; pb[i] = keep + __shfl_xor(send, msk); } } }
                float t0 = pa[0], t1 = pb[0]; t0 += __shfl_xor(t0, 2); t1 += __shfl_xor(t1, 2); t0 += __shfl_xor(t0, 1); t1 += __shfl_xor(t1, 1);
                if ((lane & 3) == 0) { const float z0 = t0 + dtb, z1 = t1 + dtb;
                    P_DT[(size_t)row0_ * 16 + oi] = z0 > 20.f ? z0 : log1pf(expf(z0)); P_DT[(size_t)(row0_ + 8) * 16 + oi] = z1 > 20.f ? z1 : log1pf(expf(z1)); }
            }
        }
    }
    SEAM(1);

    if (IN(2)) {
        PHASE_VARS
        __syncthreads();
        { pg8::Gemm g{P_HB, P_WIN, MT, 4608, 1024, 1024}; pg8::StaticOrder S; S.init(MT, 4608, G, (int)blockIdx.x); EpiProj E{(GAS bf16_t*)P_PROJ, (GAS bf16_t*)P_XBC, (const GAS float*)p.in[12], (const GAS float*)p.in[13], (GAS bf16_t*)out};
          pg8::gemm_phase<EpiProj, true>(lds, g, S, E); }
        { pg8::Gemm g{P_WIN + (size_t)4608 * 1024, P_HB, 1024, MT, 1024, 1024}; pg8::StaticOrder S; S.init(1024, MT, G, (int)blockIdx.x); EpiVT E{(GAS bf16_t*)P_VT};
          pg8::gemm_phase<EpiVT, true>(lds, g, S, E); }
    }
    SEAM(2);

    if (IN(3)) {
        PHASE_VARS
        __syncthreads();
        LAS bf16_t* tile = (LAS bf16_t*)lds + wave * (64 * 72);
        for (int un = blockIdx.x; un < 256; un += G)
        for (int j = wave; j < 24; j += 8) {
            const int b = un >> 6, c_ = (un >> 1) & 31, g_ = un & 1, tbl = j / 12, cl = j % 12;
            const int cb = cl < 8 ? 8 * g_ + cl : (cl < 10 ? 16 + 2 * g_ + (cl - 8) : 20 + 2 * g_ + (cl - 10)), tb = 2 * c_ + tbl;
            const int ch = cb * 64 + lane;
            const float w0 = (p.in[6])[ch], w1 = (p.in[6])[1536 + ch], w2 = (p.in[6])[3072 + ch], w3 = (p.in[6])[4608 + ch], bs = (p.in[7])[ch];
            const bf16_t* src = P_XBC + ((size_t)b * 4096 + tb * 64) * 1536 + ch;
            const GAS bf16_t* srcg = (const GAS bf16_t*)src;
            float u0 = 0.f, u1 = 0.f, u2 = 0.f;
            if (tb > 0) { u0 = bf2f(srcg[-3 * 1536]); u1 = bf2f(srcg[-2 * 1536]); u2 = bf2f(srcg[-1536]); }
            bf16_t raw[64];
#pragma unroll
            for (int t = 0; t < 64; ++t) raw[t] = srcg[(size_t)t * 1536];
            bf16_t* dstn; int ldn;
            if (cb < 16) { dstn = P_XC + ((size_t)b * 4096 + tb * 64) * 1024 + ch; ldn = 1024; } else { dstn = P_BC + ((size_t)b * 4096 + tb * 64) * 512 + (ch - 1024); ldn = 512; }
            GAS bf16_t* dstg = (GAS bf16_t*)dstn;
            bf16_t ybp = 0;
#pragma unroll
            for (int t = 0; t < 64; ++t) {
                const float u3 = bf2f(raw[t]);
                const float v = bs + w0 * u0 + w1 * u1 + w2 * u2 + w3 * u3;
                const float y = v * __builtin_amdgcn_rcpf(1.f + __expf(-v));
                const bf16_t yb = (bf16_t)f2bf(y);
                if (cb >= 16) dstg[(size_t)t * ldn] = yb;
                if (t & 1) ((LAS unsigned*)tile)[lane * 34 + (t >> 1)] = (unsigned)ybp | ((unsigned)yb << 16); else ybp = yb;
                u0 = u1; u1 = u2; u2 = u3;
            }
            asm volatile("s_waitcnt lgkmcnt(0)" ::: "memory");
            if (cb < 20) {
#pragma unroll
                for (int i = 0; i < 8; ++i) { const int r = i * 8 + (lane >> 3), cc = lane & 7;
                    const u32x2 va = *(const LAS u32x2*)(tile + r * 68 + cc * 8), vb = *(const LAS u32x2*)(tile + r * 68 + cc * 8 + 4);
                    u32x4 val; val.x = va.x; val.y = va.y; val.z = vb.x; val.w = vb.y;
                    bf16_t* dp;
                    if (cb < 16) dp = P_HB + (((((size_t)(b * 16 + cb) * 128 + tb * 2 + (cc >> 2)) * 4 + (r >> 4)) * 64) + (cc & 3) * 16 + (r & 15)) * 8;
                    else { const int ng = (cb - 16) * 64 + r, nn = ng & 127; dp = P_BT + (((((size_t)(b * 2 + (ng >> 7)) * 128 + tb * 2 + (cc >> 2)) * 8 + (nn >> 4)) * 64) + (cc & 3) * 16 + (nn & 15)) * 8; }
                    *(u32x4*)dp = val; }
            }
            asm volatile("s_waitcnt lgkmcnt(0)" ::: "memory");
        }
    }

    if (IN(4)) {
        PHASE_VARS
        for (int un = blockIdx.x; un < 256; un += G) {
            const int b = un >> 6, c = (un >> 1) & 31, g = un & 1, h = g * 8 + wave;
            LAS float* wl = (LAS float*)lds + wave * 128;
            asm volatile("s_waitcnt vmcnt(0)" ::: "memory");
            __syncthreads();
            const float ah = -expf((p.in[9])[h]);
            const size_t tok0 = (size_t)b * 4096 + c * 128;
            const float dt0 = ((const GAS float*)P_DT)[(tok0 + lane) * 16 + h], dt1 = ((const GAS float*)P_DT)[(tok0 + 64 + lane) * 16 + h];
            float s0, s1; chunk_cumsum(ah * dt0, ah * dt1, lane, s0, s1);
            const float last = __shfl(s1, 63);
            wl[lane] = expf(last - s0) * dt0; wl[64 + lane] = expf(last - s1) * dt1;
            if (lane == 0) P_CDEC[(b * 32 + c) * 16 + h] = expf(last);
            __syncthreads();
            f32x4 acc[4][8];
#pragma unroll
            for (int mi = 0; mi < 4; ++mi)
#pragma unroll
                for (int ni = 0; ni < 8; ++ni) acc[mi][ni] = (f32x4){0.f, 0.f, 0.f, 0.f};
            const GAS bf16_t* xt = (const GAS bf16_t*)P_HB + (((size_t)(b * 16 + h) * 128 + c * 4) * 4) * 512 + lane * 8;
            const GAS bf16_t* bt = (const GAS bf16_t*)P_BT + (((size_t)(b * 2 + g) * 128 + c * 4) * 8) * 512 + lane * 8;
#pragma unroll 2
            for (int ks = 0; ks < 4; ++ks) {
                const f32x4 wa = *(const LAS f32x4*)(wl + 32 * ks + 8 * fq), wb = *(const LAS f32x4*)(wl + 32 * ks + 8 * fq + 4);
                bf16x8 xf[4];
#pragma unroll
                for (int mi = 0; mi < 4; ++mi) { const u32x4 raw = *(const GAS u32x4*)(xt + (ks * 4 + mi) * 512); u32x4 o;
                    o.x = cvt_pk(bflo(raw.x) * wa.x, bfhi(raw.x) * wa.y); o.y = cvt_pk(bflo(raw.y) * wa.z, bfhi(raw.y) * wa.w);
                    o.z = cvt_pk(bflo(raw.z) * wb.x, bfhi(raw.z) * wb.y); o.w = cvt_pk(bflo(raw.w) * wb.z, bfhi(raw.w) * wb.w);
                    xf[mi] = __builtin_bit_cast(bf16x8, o); }
#pragma unroll
                for (int ni = 0; ni < 8; ++ni) { const bf16x8 bf = *(const GAS bf16x8*)(bt + (ks * 8 + ni) * 512);
#pragma unroll
                    for (int mi = 0; mi < 4; ++mi) acc[mi][ni] = MFMA16(bf, xf[mi], acc[mi][ni]); }
            }
            GAS bf16_t* st = (GAS bf16_t*)P_ST + ((size_t)((b * 32 + c) * 16 + h) * 64) * 128;
#pragma unroll
            for (int mi = 0; mi < 4; ++mi)
#pragma unroll
                for (int ni = 0; ni < 8; ++ni) { u32x2 w; w.x = cvt_pk(acc[mi][ni][0], acc[mi][ni][1]); w.y = cvt_pk(acc[mi][ni][2], acc[mi][ni][3]);
                    *(GAS u32x2*)(st + ((mi * 4 + (ni >> 1)) * 64 + (2 * (ni & 1) + (fq >> 1)) * 16 + fr) * 8 + 4 * (fq & 1)) = w; }
        }
    }
    SEAM(4);

    if (IN(5)) {
        PHASE_VARS
        unsigned* ST32 = (unsigned*)P_ST;
        for (int gid = blockIdx.x * 512 + tid; gid < 262144; gid += G * 512) {
            const int b = gid >> 16, rem = gid & 65535, h = rem >> 12, pn = rem & 4095;
            const GAS unsigned* sg = (const GAS unsigned*)ST32 + ((size_t)(b * 32 * 16 + h)) * 4096 + pn;
            const GAS float* dg = (const GAS float*)P_CDEC + b * 32 * 16 + h;
            unsigned vv[32]; float dd[32];
#pragma unroll
            for (int c = 0; c < 32; ++c) { vv[c] = sg[(size_t)c * 16 * 4096]; dd[c] = dg[c * 16]; }
            float r0 = 0.f, r1 = 0.f;
#pragma unroll
            for (int c = 0; c < 32; ++c) {
                ((GAS unsigned*)sg)[(size_t)c * 16 * 4096] = cvt_pk(r0, r1);
                r0 = r0 * dd[c] + bflo(vv[c]); r1 = r1 * dd[c] + bfhi(vv[c]);
            }
        }
    }
    SEAM(5);

    if (IN(6)) {
        PHASE_VARS
#ifndef SKIP_S3
        for (int un = blockIdx.x; un < 256; un += G) {
            const int b = un >> 6, c = (un >> 1) & 31, g = un & 1, h = g * 8 + wave;
            LAS float* SC = (LAS float*)lds;
            LAS float* acsl = SC + 128 * 132 + wave * 256;
            LAS float* ssqp = SC + 128 * 132 + 8 * 256;
            const size_t tok0 = (size_t)b * 4096 + c * 128;
            __syncthreads();
            {
                f32x4 sacc[8];
#pragma unroll
                for (int ni = 0; ni < 8; ++ni) sacc[ni] = (f32x4){0.f, 0.f, 0.f, 0.f};
                const GAS bf16_t* cp = (const GAS bf16_t*)P_BC + (tok0 + 16 * wave + fr) * 512 + 256 + g * 128 + 8 * fq;
                const GAS bf16_t* bp = (const GAS bf16_t*)P_BC + (tok0 + fr) * 512 + g * 128 + 8 * fq;
#pragma unroll 2
                for (int ks = 0; ks < 4; ++ks) { const bf16x8 cf = *(const GAS bf16x8*)(cp + 32 * ks);
#pragma unroll
                    for (int ni = 0; ni < 8; ++ni) if (ni <= wave) { const bf16x8 bf = *(const GAS bf16x8*)(bp + (size_t)ni * 16 * 512 + 32 * ks); sacc[ni] = MFMA16(cf, bf, sacc[ni]); } }
#pragma unroll
                for (int ni = 0; ni < 8; ++ni) if (ni <= wave) {
#pragma unroll
                    for (int r = 0; r < 4; ++r) SC[(16 * wave + 4 * fq + r) * 132 + 16 * ni + fr] = sacc[ni][r]; }
            }
            const float ah = -expf((p.in[9])[h]);
            {
                const float dt0 = ((const GAS float*)P_DT)[(tok0 + lane) * 16 + h], dt1 = ((const GAS float*)P_DT)[(tok0 + 64 + lane) * 16 + h];
                float s0, s1; chunk_cumsum(ah * dt0, ah * dt1, lane, s0, s1);
                acsl[lane] = s0; acsl[64 + lane] = s1; acsl[128 + lane] = dt0; acsl[192 + lane] = dt1;
            }
            __syncthreads();
            f32x4 acc[8][4];
#pragma unroll
            for (int mi = 0; mi < 8; ++mi)
#pragma unroll
                for (int ni = 0; ni < 4; ++ni) acc[mi][ni] = (f32x4){0.f, 0.f, 0.f, 0.f};
            {
                const GAS bf16_t* pv = (const GAS bf16_t*)P_ST + ((size_t)((b * 32 + c) * 16 + h) * 64) * 128 + lane * 8;
                const GAS bf16_t* cq = (const GAS bf16_t*)P_BC + (tok0 + fr) * 512 + 256 + g * 128 + 8 * fq;
#pragma unroll 2
                for (int ks = 0; ks < 4; ++ks) { bf16x8 pf[4];
#pragma unroll
                    for (int ni = 0; ni < 4; ++ni) pf[ni] = *(const GAS bf16x8*)(pv + (ni * 4 + ks) * 512);
#pragma unroll
                    for (int mi = 0; mi < 8; ++mi) { const bf16x8 cf = *(const GAS bf16x8*)(cq + (size_t)mi * 16 * 512 + 32 * ks);
#pragma unroll
                        for (int ni = 0; ni < 4; ++ni) acc[mi][ni] = MFMA16(pf[ni], cf, acc[mi][ni]); } }
#pragma unroll
                for (int mi = 0; mi < 8; ++mi) { const float e = __expf(acsl[16 * mi + fr]);
#pragma unroll
                    for (int ni = 0; ni < 4; ++ni) acc[mi][ni] = acc[mi][ni] * e; }
            }
            const float Dh = (p.in[10])[h];
            {
                const GAS bf16_t* xt = (const GAS bf16_t*)P_HB + (((size_t)(b * 16 + h) * 128 + c * 4) * 4) * 512 + lane * 8;
#pragma unroll 1
                for (int ks = 0; ks < 4; ++ks) { bf16x8 xf[4];
#pragma unroll
                    for (int ni = 0; ni < 4; ++ni) xf[ni] = *(const GAS bf16x8*)(xt + (ks * 4 + ni) * 512);
                    float as_[8], ds_[8];
#pragma unroll
                    for (int i = 0; i < 8; ++i) { as_[i] = acsl[32 * ks + 8 * fq + i]; ds_[i] = acsl[128 + 32 * ks + 8 * fq + i]; }
#pragma unroll
                    for (int mi = 0; mi < 8; ++mi) if (16 * mi + 15 >= 32 * ks) {
                        const int l = 16 * mi + fr; const float al = acsl[l];
                        const f32x4 g0 = *(const LAS f32x4*)(SC + l * 132 + 32 * ks + 8 * fq), g1 = *(const LAS f32x4*)(SC + l * 132 + 32 * ks + 8 * fq + 4);
                        float gv[8];
#pragma unroll
                        for (int i = 0; i < 8; ++i) { const int s = 32 * ks + 8 * fq + i; const float sc = i < 4 ? g0[i & 3] : g1[i & 3];
                            const float val = sc * __expf(al - as_[i]) * ds_[i]; gv[i] = (s <= l) ? val : 0.f; if (s == l) gv[i] += Dh; }
                        u32x4 o; o.x = cvt_pk(gv[0], gv[1]); o.y = cvt_pk(gv[2], gv[3]); o.z = cvt_pk(gv[4], gv[5]); o.w = cvt_pk(gv[6], gv[7]);
                        const bf16x8 gf = __builtin_bit_cast(bf16x8, o);
#pragma unroll
                        for (int ni = 0; ni < 4; ++ni) acc[mi][ni] = MFMA16(xf[ni], gf, acc[mi][ni]); }
                }
            }
            {
#pragma unroll
                for (int mi = 0; mi < 8; ++mi) { const int l = 16 * mi + fr; const size_t tok = tok0 + l; float s = 0.f;
#pragma unroll
                    for (int ni = 0; ni < 4; ++ni) { const int ch = h * 64 + 16 * ni + 4 * fq;
                        const u32x2 zz = *(const GAS u32x2*)((const GAS bf16_t*)P_PROJ + tok * 3072 + ch);
                        const float zv[4] = {bflo(zz.x), bfhi(zz.x), bflo(zz.y), bfhi(zz.y)};
#pragma unroll
                        for (int e = 0; e < 4; ++e) { float y = acc[mi][ni][e]; y *= zv[e] * __builtin_amdgcn_rcpf(1.f + __expf(-zv[e])); acc[mi][ni][e] = y; s += y * y; } }
                    s += __shfl_xor(s, 16); s += __shfl_xor(s, 32);
                    if (fq == 0) ssqp[wave * 128 + l] = s; }
                __syncthreads();
#pragma unroll
                for (int mi = 0; mi < 8; ++mi) { const int l = 16 * mi + fr; const size_t tok = tok0 + l; float tot = 0.f;
#pragma unroll
                    for (int w = 0; w < 8; ++w) tot += ssqp[w * 128 + l];
                    const float rstd = 1.0f / sqrtf(tot * (1.f / 512.f) + 1e-6f);
#pragma unroll
                    for (int ni = 0; ni < 4; ++ni) { const int ch = h * 64 + 16 * ni + 4 * fq; const f32x4 nw4 = *(const GAS f32x4*)((const GAS float*)(p.in[11]) + ch);
                        u32x2 w; w.x = cvt_pk(acc[mi][ni][0] * rstd * nw4.x, acc[mi][ni][1] * rstd * nw4.y); w.y = cvt_pk(acc[mi][ni][2] * rstd * nw4.z, acc[mi][ni][3] * rstd * nw4.w);
                        *(GAS u32x2*)((GAS bf16_t*)P_PROJ + tok * 3072 + ch) = w; } }
            }
        }
#endif
#ifndef SKIP_ATT
        for (int it = 0;; ++it) {
            int qt, bh;
            if ((G & 7) == 0) {
                int uidx = 0;
                if (lane == 0) uidx = (int)__hip_atomic_fetch_add((unsigned*)(p.ws + WS_BAR) + 3520 + 64 * (blockIdx.x & 7), 1u, __ATOMIC_RELAXED, __HIP_MEMORY_SCOPE_AGENT);
                uidx = __builtin_amdgcn_readfirstlane(uidx);
                if (uidx >= 1024) break; qt = uidx & 127; bh = (blockIdx.x & 7) + 8 * (uidx >> 7); }
            else { const int wu = gw + it * NGW; if (wu >= 8192) break; qt = wu & 127; bh = wu >> 7; }
            const int b = bh >> 4, h = bh & 15, q0 = qt * 32;
            bf16_t* qp = P_PROJ + ((size_t)b * 4096 + q0 + fr) * 3072 + 1024 + h * 64;
            const GAS bf16_t* qg = (const GAS bf16_t*)qp;
            bf16x8 qf[2][2];
#pragma unroll
            for (int t = 0; t < 2; ++t) { qf[t][0] = *(const GAS bf16x8*)(qg + (size_t)t * 16 * 3072 + 8 * fq); qf[t][1] = *(const GAS bf16x8*)(qg + (size_t)t * 16 * 3072 + 32 + 8 * fq); }
            f32x4 o[2][4];
#pragma unroll
            for (int t = 0; t < 2; ++t)
#pragma unroll
                for (int di = 0; di < 4; ++di) o[t][di] = (f32x4){0.f, 0.f, 0.f, 0.f};
            float carry[2] = {0.f, 0.f};
            const GAS bf16_t* kbase = (const GAS bf16_t*)out + (size_t)bh * (256 * 1024) + lane * 8;
            const GAS bf16_t* vbase = (const GAS bf16_t*)P_VT + (size_t)bh * (128 * 2048) + lane * 8;
            int kb = (q0 + 30) >> 6;
            bf16x8 kc[8];
#pragma unroll
            for (int ki = 0; ki < 4; ++ki) { const GAS bf16_t* kp = kbase + (size_t)(kb * 4 + ki) * 1024; kc[2 * ki] = *(const GAS bf16x8*)kp; kc[2 * ki + 1] = *(const GAS bf16x8*)(kp + 512); }
            for (;;) {
                const int j0 = kb * 64;
                bf16x8 vv[8];
#pragma unroll
                for (int kk = 0; kk < 2; ++kk)
#pragma unroll
                    for (int di = 0; di < 4; ++di) vv[kk * 4 + di] = *(const GAS bf16x8*)(vbase + (size_t)(((j0 >> 5) + kk) * 4 + di) * 512);
                bf16x8 kn[8];
                { const int jn = (kb > 0 ? kb - 1 : 0) * 64;
#pragma unroll
                  for (int ki = 0; ki < 4; ++ki) { const GAS bf16_t* kp = kbase + (size_t)((jn >> 4) + ki) * 1024; kn[2 * ki] = *(const GAS bf16x8*)kp; kn[2 * ki + 1] = *(const GAS bf16x8*)(kp + 512); } }
                const bool diag = j0 + 63 >= q0;
#pragma unroll
                for (int t = 0; t < 2; ++t) {
                    const int qlim = diag ? q0 + 16 * t + fr : 0x7fffffff;
                    f32x4 s[4];
#pragma unroll
                    for (int ki = 0; ki < 4; ++ki) { s[ki] = MFMA16(kc[2 * ki], qf[t][0], ((f32x4){0.f, 0.f, 0.f, 0.f})); s[ki] = MFMA16(kc[2 * ki + 1], qf[t][1], s[ki]); }
                    float sp[4][4], lw[4][4], gs[4], rowtot[4], above[4];
#pragma unroll
                    for (int ki = 0; ki < 4; ++ki) {
#pragma unroll
                        for (int r = 0; r < 4; ++r) { const float l = s[ki][r];
                            const float spv = fmaxf(l, 0.f) + __builtin_amdgcn_logf(1.f + __builtin_amdgcn_exp2f(-fabsf(l)));
                            const int key = j0 + 16 * ki + 4 * fq + r;
                            sp[ki][r] = key < qlim ? spv : 0.f; lw[ki][r] = l - spv; }
                        gs[ki] = (sp[ki][0] + sp[ki][1]) + (sp[ki][2] + sp[ki][3]);
                        const float g16 = __shfl_xor(gs[ki], 16), g32 = __shfl_xor(gs[ki], 32), g48 = __shfl_xor(gs[ki], 48);
                        rowtot[ki] = (gs[ki] + g16) + (g32 + g48);
                        above[ki] = ((fq ^ 1) > fq ? g16 : 0.f) + ((fq ^ 2) > fq ? g32 : 0.f) + ((fq ^ 3) > fq ? g48 : 0.f);
                    }
                    float run = carry[t]; float wv[4][4];
#pragma unroll
                    for (int ki = 3; ki >= 0; --ki) { const float r3 = run + above[ki], r2 = r3 + sp[ki][3], r1 = r2 + sp[ki][2], r0 = r1 + sp[ki][1];
                        const int key0 = j0 + 16 * ki + 4 * fq;
                        wv[ki][3] = key0 + 3 < qlim ? __builtin_amdgcn_exp2f(lw[ki][3] - r3) : 0.f; wv[ki][2] = key0 + 2 < qlim ? __builtin_amdgcn_exp2f(lw[ki][2] - r2) : 0.f;
                        wv[ki][1] = key0 + 1 < qlim ? __builtin_amdgcn_exp2f(lw[ki][1] - r1) : 0.f; wv[ki][0] = key0 < qlim ? __builtin_amdgcn_exp2f(lw[ki][0] - r0) : 0.f;
                        run += rowtot[ki]; }
                    carry[t] = run;
#pragma unroll
                    for (int kk = 0; kk < 2; ++kk) { u32x4 pw; pw.x = cvt_pk(wv[2 * kk][0], wv[2 * kk][1]); pw.y = cvt_pk(wv[2 * kk][2], wv[2 * kk][3]);
                        pw.z = cvt_pk(wv[2 * kk + 1][0], wv[2 * kk + 1][1]); pw.w = cvt_pk(wv[2 * kk + 1][2], wv[2 * kk + 1][3]);
                        const bf16x8 pf = __builtin_bit_cast(bf16x8, pw);
#pragma unroll
                        for (int di = 0; di < 4; ++di) o[t][di] = MFMA16(vv[kk * 4 + di], pf, o[t][di]); }
                }
                if (kb == 0 || __all(fminf(carry[0], carry[1]) > 57.71f)) break;
                --kb;
#pragma unroll
                for (int i = 0; i < 8; ++i) kc[i] = kn[i];
            }
#pragma unroll
            for (int t = 0; t < 2; ++t)
#pragma unroll
                for (int di = 0; di < 4; ++di) { u32x2 w; w.x = cvt_pk(o[t][di][0], o[t][di][1]); w.y = cvt_pk(o[t][di][2], o[t][di][3]);
                    *(GAS u32x2*)((GAS bf16_t*)qp + (size_t)t * 16 * 3072 + 16 * di + 4 * fq) = w; }
        }
#endif
    }
    SEAM(6);

    if (IN(7)) {
        PHASE_VARS
        __syncthreads();
        pg8::Gemm g{P_PROJ, P_WOUT, MT, 1024, 2048, 3072}; pg8::StaticOrder S; S.init(MT, 1024, G, (int)blockIdx.x); EpiRes E{(const GAS float*)p.in[0], (GAS float*)out, (const GAS float*)(P_MOD + 2048)};
        pg8::gemm_phase<EpiRes, true>(lds, g, S, E);
    }
    SEAM(7);

    if (IN(8)) {
        PHASE_VARS
        for (int row0_ = gw; row0_ < MT; row0_ += 2 * NGW) {
            f32x4 v[2][4]; float ss[2] = {0.f, 0.f};
#pragma unroll
            for (int q = 0; q < 2; ++q)
#pragma unroll
                for (int j = 0; j < 4; ++j) { const int row = row0_ + q * NGW < MT ? row0_ + q * NGW : row0_;
                    v[q][j] = *(const GAS f32x4*)((const GAS float*)out + (size_t)row * 1024 + 4 * lane + 256 * j);
                    ss[q] += (v[q][j].x * v[q][j].x + v[q][j].y * v[q][j].y) + (v[q][j].z * v[q][j].z + v[q][j].w * v[q][j].w); }
#pragma unroll
            for (int q = 0; q < 2; ++q) { const int row = row0_ + q * NGW; if (row < MT) {
                const int b = row >> 12;
                const float rstd = 1.0f / sqrtf(wave_sum(ss[q]) * (1.f / 1024.f) + 1e-6f);
#pragma unroll
                for (int j = 0; j < 4; ++j) { const int k = 4 * lane + 256 * j;
                    const f32x4 nw = *(const f32x4*)((p.in[15]) + k), sc = *(const f32x4*)(P_MOD + b * 6144 + 4096 + k), sh = *(const f32x4*)(P_MOD + b * 6144 + 3072 + k);
                    const f32x4 hv = v[q][j] * rstd * nw * (sc + 1.f) + sh;
                    u32x2 w; w.x = cvt_pk(hv.x, hv.y); w.y = cvt_pk(hv.z, hv.w);
                    *(GAS u32x2*)((GAS bf16_t*)P_HB + (size_t)row * 1024 + k) = w; } } }
        }
    }
    SEAM(8);

    if (IN(9)) {
        PHASE_VARS
        __syncthreads();
        pg8::Gemm g{P_HB, P_WGU, MT, 5632, 1024, 1024}; pg8::StaticOrder S; S.init(MT, 5632, G, (int)blockIdx.x); EpiGU E{(GAS bf16_t*)P_ACT};
        pg8::gemm_phase<EpiGU, true>(lds, g, S, E);
    }
    SEAM(9);

    if (IN(10)) {
        PHASE_VARS
        __syncthreads();
        pg8::Gemm g{P_ACT, P_WDN, MT, 1024, DFF, DFF}; pg8::StaticOrder S; S.init(MT, 1024, G, (int)blockIdx.x); EpiRes E{(const GAS float*)out, (GAS float*)out, (const GAS float*)(P_MOD + 5120)};
        pg8::gemm_phase<EpiRes, true>(lds, g, S, E);
    }

#ifdef DBG_HI
    GRID_BAR();
    {   PHASE_VARS
        for (size_t i = (size_t)blockIdx.x * 512 + tid; i < (size_t)MT * 1024; i += (size_t)G * 512) {
            const size_t m = i >> 10, c = i & 1023;
            out[i] = DBG_EXPR;
        }
    }
#endif
#undef IN
#undef SEAM
}

extern "C" void kernel_launch(void* const* d_in, const int* in_sizes, int n_in, void* d_out, int out_size, void* d_ws, size_t ws_size, hipStream_t stream) {
    static int grid = 0;
    if (grid == 0) {
        if (n_in != 19 || out_size != MT * DM || ws_size < WS_END) { fprintf(stderr, "kernel_launch: unexpected shapes (n_in %d out %d ws %zu)\n", n_in, out_size, ws_size); grid = -1; return; }
        int dev = 0, cus = 0, per_cu = 0;
        hipGetDevice(&dev);
        hipDeviceGetAttribute(&cus, hipDeviceAttributeMultiprocessorCount, dev);
        hipFuncSetAttribute((const void*)fwd, hipFuncAttributeMaxDynamicSharedMemorySize, LDS_BYTES);
        hipOccupancyMaxActiveBlocksPerMultiprocessor(&per_cu, (const void*)fwd, 512, LDS_BYTES);
        if (per_cu < 1) { fprintf(stderr, "kernel_launch: occupancy query says %d blocks/CU\n", per_cu); per_cu = 1; }
        grid = cus * per_cu;
    }
    if (grid < 0) return;
    if (hipMemsetAsync((char*)d_ws + WS_BAR, 0, 16384, stream) != hipSuccess) { fprintf(stderr, "kernel_launch: memset failed\n"); return; }
    Params p{};
    for (int i = 0; i < 19; ++i) p.in[i] = (const float*)d_in[i];
    p.out = (float*)d_out; p.ws = (unsigned char*)d_ws; p.ph_lo = 0;
#ifdef DBG_HI
    p.ph_hi = DBG_HI;
#else
    p.ph_hi = 11;
#endif
    void* args[] = {&p};
    hipError_t e = hipLaunchCooperativeKernel((const void*)fwd, dim3(grid), dim3(512), args, LDS_BYTES, stream);
    if (e != hipSuccess) fprintf(stderr, "cooperative launch failed: %s (grid %d)\n", hipGetErrorString(e), grid);
}
```

```cpp
#include <hip/hip_runtime.h>
#include <hip/hip_cooperative_groups.h>
#include <cstdio>
#include <cstdint>
namespace cg = cooperative_groups;

#define LAS __attribute__((address_space(3)))
#define GAS __attribute__((address_space(1)))
typedef unsigned short bf16_t;
typedef short bf16x8 __attribute__((ext_vector_type(8)));
typedef float f32x4 __attribute__((ext_vector_type(4)));
typedef unsigned u32x4 __attribute__((ext_vector_type(4)));
typedef unsigned u32x2 __attribute__((ext_vector_type(2)));

__device__ __forceinline__ unsigned f2bf(float f) { unsigned u = __builtin_bit_cast(unsigned, f); return (u + 0x7fffu + ((u >> 16) & 1u)) >> 16; }
typedef __bf16 bf16x2_t __attribute__((ext_vector_type(2)));
typedef float f32x2_t __attribute__((ext_vector_type(2)));
__device__ __forceinline__ unsigned cvt_pk(float lo, float hi) { const f32x2_t v = {lo, hi}; const bf16x2_t b = __builtin_convertvector(v, bf16x2_t); return __builtin_bit_cast(unsigned, b); }
__device__ __forceinline__ float bflo(unsigned w) { return __builtin_bit_cast(float, w << 16); }
__device__ __forceinline__ float bfhi(unsigned w) { return __builtin_bit_cast(float, w & 0xffff0000u); }
__device__ __forceinline__ float bf2f(bf16_t b) { return __builtin_bit_cast(float, (unsigned)b << 16); }
__device__ __forceinline__ float wave_sum(float v) {
#pragma unroll
    for (int o = 1; o < 64; o <<= 1) v += __shfl_xor(v, o);
    return v;
}
#define MFMA16(a, b, c) __builtin_amdgcn_mfma_f32_16x16x32_bf16((a), (b), (c), 0, 0, 0)

namespace pg8 {
constexpr int BM = 256, BK = 64, HALF = 128, HTB = HALF * BK * 2, STAGE_BYTES = 8 * HTB, NXCD = 8, WGM = 8;
__host__ __device__ __forceinline__ int lds_byte(int r, int c) { const int st = (r >> 4) * 2 + (c >> 5), rr = r & 15, cc = c & 31, ob = rr * 64 + cc * 2; return st * 1024 + (ob ^ (((ob >> 9) & 1) << 5)); }
__host__ __device__ __forceinline__ void stage_rc(int b, int& R, int& C) { const int st = b / 1024, sb = b % 1024, swz = sb ^ (((sb >> 9) & 1) << 5); R = (st >> 1) * 16 + swz / 64; C = (st & 1) * 32 + (swz % 64) / 2; }
__host__ __device__ __forceinline__ int perm32(int rho) { const int n = rho >> 4, i = rho & 15; return 8 * (i >> 2) + 4 * n + (i & 3); }
struct Unit { int pm, pn; };
struct Gemm { const bf16_t* A; const bf16_t* Bt; int M, N, K, lda; };
struct StaticOrder {
    int nM, nN, nwg, G, c;
    __device__ void init(int M, int N, int G_, int c_) { nM = M / BM; nN = N / BM; nwg = nM * nN; G = G_; c = c_; }
    __device__ bool next(int i, Unit& u) const {
        const long L = (long)i * G + c; if (L >= nwg) return false;
        int wgid = (int)L; { const int q = nwg / NXCD, r = nwg % NXCD, xcd = wgid % NXCD, off = wgid / NXCD; wgid = (xcd < r ? xcd * (q + 1) : r * (q + 1) + (xcd - r) * q) + off; }
        const int nig = WGM * nN, gid = wgid / nig, fm = gid * WGM, gsz = (nM - fm) < WGM ? (nM - fm) : WGM;
        u.pm = fm + ((wgid % nig) % gsz); u.pn = (wgid % nig) / gsz; return true;
    }
};

template <class Epi, bool ALIGN_EPI>
__device__ __forceinline__ void gemm_phase(LAS unsigned char* lds, const Gemm g, const StaticOrder& S, const Epi& E) {
    const int tid = threadIdx.x, wid = __builtin_amdgcn_readfirstlane(tid >> 6), lane = tid & 63, wr = wid >> 2, wc = wid & 3, fr = lane & 15, fq = lane >> 4;
    const int K = g.K, nt = K / BK, lda = g.lda;
    unsigned voffA[2], voffB[2];
#pragma unroll
    for (int i = 0; i < 2; ++i) { int R, C; stage_rc(tid * 16 + i * 8192, R, C); const int Rb = Epi::PERM ? ((R & ~31) + perm32(R & 31)) : R;
        voffA[i] = (unsigned)(R * lda + C) * 2u; voffB[i] = (unsigned)(Rb * K + C) * 2u; }
    const size_t kstep = (size_t)(BK * 2);
    const size_t hstepA = (size_t)HALF * lda * 2, hstepB = (size_t)HALF * K * 2;
    const size_t tstepA = 2 * hstepA, tstepB = 2 * hstepB;
    const unsigned ldsw = (unsigned)wid * 1024u;
    const int aoff = lds_byte(wr * 64 + fr, fq * 8), boff = lds_byte(wc * 32 + fr, fq * 8);
#define PG8_SA(b, h) (((b) * 2 + (h)) * HTB)
#define PG8_SB(b, h) ((4 + (b) * 2 + (h)) * HTB)
#define PG8_STAGE(bufoff, gbase, voff) do { _Pragma("unroll") for (int _i = 0; _i < 2; ++_i) \
        __builtin_amdgcn_global_load_lds((const unsigned*)((const char*)(gbase) + (voff)[_i]), (LAS unsigned*)(lds + (bufoff) + ldsw + _i * 8192), 16, 0, 0); } while (0)
#define PG8_LDA(dst, b, h) do { _Pragma("unroll") for (int m = 0; m < 4; ++m) _Pragma("unroll") for (int k = 0; k < 2; ++k) dst[m][k] = *(const LAS bf16x8*)(lds + PG8_SA(b, h) + aoff + m * 2048 + k * 1024); } while (0)
#define PG8_LDB(dst, b, h) do { _Pragma("unroll") for (int n = 0; n < 2; ++n) _Pragma("unroll") for (int k = 0; k < 2; ++k) dst[n][k] = *(const LAS bf16x8*)(lds + PG8_SB(b, h) + boff + n * 2048 + k * 1024); } while (0)
#define PG8_MMA(ai, bj, At, Bt) do { __builtin_amdgcn_s_setprio(1); _Pragma("unroll") for (int m = 0; m < 4; ++m) _Pragma("unroll") for (int n = 0; n < 2; ++n) _Pragma("unroll") for (int k = 0; k < 2; ++k) \
        acc[ai][bj][m][n] = __builtin_amdgcn_mfma_f32_16x16x32_bf16(Bt[n][k], At[m][k], acc[ai][bj][m][n], 0, 0, 0); __builtin_amdgcn_s_setprio(0); } while (0)
#define PG8_WAIT_V(n) asm volatile("s_waitcnt vmcnt(" #n ")" ::: "memory")
#define PG8_WAIT_L(n) asm volatile("s_waitcnt lgkmcnt(" #n ")" ::: "memory")
#define PG8_BAR __builtin_amdgcn_s_barrier()
#define PG8_SCHED __builtin_amdgcn_sched_barrier(0)
    Unit cur, nxt; int ui = 0;
    if (!S.next(0, cur)) return;
    f32x4 acc[2][2][4][2];
#pragma unroll
    for (int a = 0; a < 2; ++a)
#pragma unroll
        for (int b = 0; b < 2; ++b)
#pragma unroll
            for (int m = 0; m < 4; ++m)
#pragma unroll
                for (int n = 0; n < 2; ++n) acc[a][b][m][n] = (f32x4){0.f, 0.f, 0.f, 0.f};
    bf16x8 At[4][2], B0[2][2], B1[2][2];
    const char* cA = (const char*)g.A + (size_t)cur.pm * tstepA; const char* cB = (const char*)g.Bt + (size_t)cur.pn * tstepB;
    PG8_STAGE(PG8_SB(0, 0), cB, voffB); PG8_STAGE(PG8_SB(0, 1), cB + hstepB, voffB); PG8_STAGE(PG8_SA(0, 0), cA, voffA); PG8_STAGE(PG8_SA(0, 1), cA + hstepA, voffA);
    if (wr == 1) PG8_BAR;
    PG8_WAIT_V(2); PG8_BAR;
    PG8_STAGE(PG8_SB(1, 0), cB + kstep, voffB); PG8_STAGE(PG8_SA(1, 0), cA + kstep, voffA); PG8_STAGE(PG8_SB(1, 1), cB + hstepB + kstep, voffB);
    PG8_WAIT_V(6); PG8_BAR;
    for (;;) {
        const bool has_next = S.next(ui + 1, nxt);
        const char* nA = has_next ? (const char*)g.A + (size_t)nxt.pm * tstepA : cA; const char* nB = has_next ? (const char*)g.Bt + (size_t)nxt.pn * tstepB : cB;
        for (int t = 0; t < nt; t += 2) {
            const bool last = (t == nt - 2);
            const char* a1 = cA + (size_t)(t + 1) * kstep;
            const char* a2 = last ? nA : cA + (size_t)(t + 2) * kstep; const char* b2 = last ? nB : cB + (size_t)(t + 2) * kstep;
            const char* a3 = a2 + kstep; const char* b3 = b2 + kstep;
            PG8_LDB(B0, 0, 0); PG8_LDB(B1, 0, 1); PG8_SCHED; PG8_LDA(At, 0, 0); PG8_STAGE(PG8_SA(1, 1), a1 + hstepA, voffA);
            PG8_WAIT_V(8); PG8_WAIT_L(0); PG8_BAR; PG8_MMA(0, 0, At, B0); PG8_MMA(0, 1, At, B1); PG8_BAR; PG8_SCHED;
            PG8_LDA(At, 0, 1); PG8_STAGE(PG8_SB(0, 0), b2, voffB); PG8_STAGE(PG8_SB(0, 1), b2 + hstepB, voffB); PG8_STAGE(PG8_SA(0, 0), a2, voffA);
            PG8_WAIT_V(8); PG8_WAIT_L(0); PG8_BAR; PG8_MMA(1, 0, At, B0); PG8_MMA(1, 1, At, B1); PG8_BAR; PG8_SCHED;
            PG8_LDB(B0, 1, 0); PG8_LDB(B1, 1, 1); PG8_SCHED; PG8_LDA(At, 1, 0); PG8_STAGE(PG8_SA(0, 1), a2 + hstepA, voffA);
            PG8_WAIT_V(8); PG8_WAIT_L(0); PG8_BAR; PG8_MMA(0, 0, At, B0); PG8_MMA(0, 1, At, B1); PG8_BAR; PG8_SCHED;
            PG8_LDA(At, 1, 1); PG8_STAGE(PG8_SB(1, 0), b3, voffB); PG8_STAGE(PG8_SB(1, 1), b3 + hstepB, voffB); PG8_STAGE(PG8_SA(1, 0), a3, voffA);
            PG8_WAIT_V(8); PG8_WAIT_L(0); PG8_BAR; PG8_MMA(1, 0, At, B0); PG8_MMA(1, 1, At, B1); PG8_BAR; PG8_SCHED;
        }
        if constexpr (ALIGN_EPI) { if (wr == 0) PG8_BAR; }
        E(acc, cur, wr, wc, fr, fq);
        if (!has_next) break;
#pragma unroll
        for (int a = 0; a < 2; ++a)
#pragma unroll
            for (int b = 0; b < 2; ++b)
#pragma unroll
                for (int m = 0; m < 4; ++m)
#pragma unroll
                    for (int n = 0; n < 2; ++n) acc[a][b][m][n] = (f32x4){0.f, 0.f, 0.f, 0.f};
        cur = nxt; cA = nA; cB = nB; ++ui;
        if constexpr (ALIGN_EPI) { if (wr == 1) PG8_BAR; }
    }
    PG8_WAIT_V(0);
    if constexpr (!ALIGN_EPI) { if (wr == 0) PG8_BAR; }
    PG8_BAR;
#undef PG8_SA
#undef PG8_SB
#undef PG8_STAGE
#undef PG8_LDA
#undef PG8_LDB
#undef PG8_MMA
#undef PG8_WAIT_V
#undef PG8_WAIT_L
#undef PG8_BAR
#undef PG8_SCHED
}
}

constexpr int NB = 4, SEQ = 4096, DM = 1024, MT = NB * SEQ, DIN = 5648, DFF = 2816;
constexpr size_t MiB = 1u << 20;
constexpr size_t WS_MODP = 0;
constexpr size_t WS_MOD = 1536 * 1024;
constexpr size_t WS_CDEC = WS_MOD + 98304;
constexpr size_t WS_BAR = 1792 * 1024;
constexpr size_t WS_WIN = 2 * MiB;
constexpr size_t WS_WOUT = 13 * MiB;
constexpr size_t WS_WGU = 17 * MiB;
constexpr size_t WS_WDN = 28 * MiB;
constexpr size_t WS_DT = 34 * MiB;
constexpr size_t WS_H = 35 * MiB;
constexpr size_t WS_PROJ = 67 * MiB;
constexpr size_t WS_VT = 163 * MiB;
constexpr size_t WS_XBC = 195 * MiB;
constexpr size_t WS_END = 243 * MiB;
constexpr size_t WS_ACT = WS_PROJ;
constexpr size_t WS_ST = WS_XBC;
constexpr int LDS_BYTES = 147456;

struct Params { const float* in[19]; float* out; unsigned char* ws; int ph_lo, ph_hi; };


#define XB_TMO      128
#define XB_XCNT(j)  (256  + 64 * (j))
#define XB_XSUB(j)  (1280 + 64 * (j))
#define XB_XGEN(j)  (2304 + 64 * (j))
#define XB_TOP      3328
#define XB_TOPGEN   3392
#define XCD_BAR_WORDS 3456
#define XB_SPIN_CAP (1u << 18)
__device__ __forceinline__ unsigned xb_ld(unsigned* p)              { return __hip_atomic_load(p, __ATOMIC_RELAXED, __HIP_MEMORY_SCOPE_AGENT); }
__device__ __forceinline__ unsigned xb_add(unsigned* p, unsigned v) { return __hip_atomic_fetch_add(p, v, __ATOMIC_RELAXED, __HIP_MEMORY_SCOPE_AGENT); }
__device__ __forceinline__ unsigned xb_xcc_id() { return (unsigned)__builtin_amdgcn_s_getreg((3 << 11) | 20) & 0xFu; }
#define XB_SPIN(cond, bar) do { unsigned _sp = 0; while (cond) { __builtin_amdgcn_s_sleep(1); \
    if ((++_sp & 255u) == 0u) { if (xb_ld(&(bar)[XB_TMO])) break; if (_sp > XB_SPIN_CAP) { atomicAdd(&(bar)[XB_TMO], 1u); break; } } } } while (0)
__device__ __forceinline__ void xcd_barrier_complete(unsigned* bar, unsigned x, unsigned& nloc, unsigned& nx) {
    const unsigned G = gridDim.x * gridDim.y * gridDim.z;
    unsigned sum, cnt, mine, sp = 0u;
    for (;;) {
        sum = 0u; cnt = 0u; mine = 0u;
#pragma unroll
        for (unsigned j = 0; j < 16; ++j) { const unsigned c = xb_ld(&bar[XB_XCNT(j)]); sum += c; cnt += (c > 0u) ? 1u : 0u; mine = (j == x) ? c : mine; }
        if (sum == G) break;
        __builtin_amdgcn_s_sleep(1);
        if ((++sp & 255u) == 0u) { if (xb_ld(&bar[XB_TMO])) break; if (sp > XB_SPIN_CAP) { atomicAdd(&bar[XB_TMO], 1u); break; } }
    }
    nloc = mine > 0u ? mine : 1u; nx = cnt > 0u ? cnt : 1u;
}
__device__ __forceinline__ void xcd_barrier(unsigned* bar, volatile LAS unsigned* st) {
    asm volatile("s_waitcnt vmcnt(0)" ::: "memory");
    __syncthreads();
    if (threadIdx.x == 0) {
        const unsigned x = xb_xcc_id();
        __builtin_amdgcn_s_waitcnt(0);
        unsigned nloc = st[0], nx = st[1];
        if (nloc == 0u) { xcd_barrier_complete(bar, x, nloc, nx); st[0] = nloc; st[1] = nx; }
        const unsigned old = xb_add(&bar[XB_XSUB(x)], 1u);
        const unsigned gen = old / nloc;
        if (old + 1u == (gen + 1u) * nloc) {
            __builtin_amdgcn_fence(__ATOMIC_RELEASE, "agent");
            asm volatile("s_waitcnt vmcnt(0)" ::: "memory");
            const unsigned og = xb_add(&bar[XB_TOP], 1u);
            const unsigned tg = og / nx;
            if (og + 1u == (tg + 1u) * nx) xb_add(&bar[XB_TOPGEN], 1u);
            else XB_SPIN(xb_ld(&bar[XB_TOPGEN]) == tg, bar);
            __builtin_amdgcn_fence(__ATOMIC_ACQUIRE, "agent");
            xb_add(&bar[XB_XGEN(x)], 1u);
            asm volatile("s_waitcnt vmcnt(0)" ::: "memory");
        } else {
            XB_SPIN(xb_ld(&bar[XB_XGEN(x)]) == gen, bar);
            __builtin_amdgcn_fence(__ATOMIC_ACQUIRE, "agent");
            asm volatile("s_waitcnt vmcnt(0)" ::: "memory");
        }
    }
    __syncthreads();
}

__device__ __forceinline__ void wt16(__amdgpu_buffer_rsrc_t r, long byteoff, u32x4 v) { __builtin_amdgcn_raw_buffer_store_b128(v, r, (int)byteoff, 0, 16); }

struct EpiProj {
    static constexpr bool PERM = true;
    GAS bf16_t* P; GAS bf16_t* X; const GAS float* qnw; const GAS float* knw; GAS bf16_t* KF;
    __device__ __forceinline__ void operator()(const f32x4 (&acc)[2][2][4][2], const pg8::Unit& u, int wr, int wc, int fr, int fq) const {
        const int row0 = u.pm * 256 + wr * 64 + fr;
        if (u.pn >= 4 && u.pn < 12) {
            const bool isq = u.pn < 8; const GAS float* nw = isq ? qnw : knw; const float sc = isq ? 0.125f * 1.44269504089f : 1.f;
            const int colb = (isq ? 1024 : 2048) + 64 * (4 * (u.pn & 3) + wc) + 8 * fq;
            f32x4 w4[2][2];
#pragma unroll
            for (int bj = 0; bj < 2; ++bj)
#pragma unroll
                for (int n = 0; n < 2; ++n) w4[bj][n] = *(const GAS f32x4*)(nw + 32 * bj + 8 * fq + 4 * n) * sc;
#pragma unroll
            for (int ai = 0; ai < 2; ++ai)
#pragma unroll
                for (int m = 0; m < 4; ++m) { float ss = 0.f;
#pragma unroll
                    for (int bj = 0; bj < 2; ++bj)
#pragma unroll
                        for (int n = 0; n < 2; ++n) { const f32x4 v = acc[ai][bj][m][n]; ss += (v[0] * v[0] + v[1] * v[1]) + (v[2] * v[2] + v[3] * v[3]); }
                    ss += __shfl_xor(ss, 16); ss += __shfl_xor(ss, 32);
                    const float rstd = 1.0f / sqrtf(ss * (1.f / 64.f) + 1e-6f);
                    const int row = row0 + ai * 128 + m * 16;
                    GAS bf16_t* rowp = P + (size_t)row * 3072 + colb;
                    GAS bf16_t* kfp = KF + ((((size_t)((row >> 12) * 16 + 4 * (u.pn & 3) + wc) * 256 + ((row & 4095) >> 4)) * 2) * 64 + fq * 16 + fr) * 8;
#pragma unroll
                    for (int bj = 0; bj < 2; ++bj) { const f32x4 v0 = acc[ai][bj][m][0] * rstd * w4[bj][0], v1 = acc[ai][bj][m][1] * rstd * w4[bj][1];
                        u32x4 w; w.x = cvt_pk(v0[0], v0[1]); w.y = cvt_pk(v0[2], v0[3]); w.z = cvt_pk(v1[0], v1[1]); w.w = cvt_pk(v1[2], v1[3]);
                        if (isq) *(GAS u32x4*)(rowp + bj * 32) = w; else *(GAS u32x4*)(kfp + bj * 512) = w; } }
            return;
        }
        GAS bf16_t* base; int ldc, colt;
        if (u.pn < 12) { base = P; ldc = 3072; colt = u.pn * 256; } else { base = X; ldc = 1536; colt = (u.pn - 12) * 256; }
        const int col0 = colt + wc * 32 + 8 * fq;
#pragma unroll
        for (int ai = 0; ai < 2; ++ai)
#pragma unroll
            for (int m = 0; m < 4; ++m) { GAS bf16_t* rowp = base + (size_t)(row0 + ai * 128 + m * 16) * ldc + col0;
#pragma unroll
                for (int bj = 0; bj < 2; ++bj) { const f32x4 v0 = acc[ai][bj][m][0], v1 = acc[ai][bj][m][1];
                    u32x4 w; w.x = cvt_pk(v0[0], v0[1]); w.y = cvt_pk(v0[2], v0[3]); w.z = cvt_pk(v1[0], v1[1]); w.w = cvt_pk(v1[2], v1[3]);
                    *(GAS u32x4*)(rowp + bj * 128) = w; } }
    }
};
struct EpiVT {
    static constexpr bool PERM = true;
    GAS bf16_t* VT;
    __device__ __forceinline__ void operator()(const f32x4 (&acc)[2][2][4][2], const pg8::Unit& u, int wr, int wc, int fr, int fq) const {
        const int b = u.pn >> 4, row0 = u.pm * 256 + wr * 64 + fr, qa = 2 * (fq & 1), hi = fq >> 1;
#pragma unroll
        for (int ai = 0; ai < 2; ++ai)
#pragma unroll
            for (int m = 0; m < 4; ++m) { const int c = row0 + ai * 128 + m * 16;
#pragma unroll
                for (int bj = 0; bj < 2; ++bj) { const f32x4 v0 = acc[ai][bj][m][0], v1 = acc[ai][bj][m][1];
                    const int tg = (u.pn & 15) * 8 + wc + bj * 4;
                    GAS bf16_t* vp = VT + (((((size_t)(b * 16 + (c >> 6)) * 128 + tg) * 4 + ((c >> 4) & 3)) * 64) + qa * 16 + fr) * 8 + 4 * hi;
                    u32x2 wa, wb; wa.x = cvt_pk(v0[0], v0[1]); wa.y = cvt_pk(v0[2], v0[3]); wb.x = cvt_pk(v1[0], v1[1]); wb.y = cvt_pk(v1[2], v1[3]);
                    *(GAS u32x2*)vp = wa; *(GAS u32x2*)(vp + 128) = wb; } }
    }
};
struct EpiRes {
    static constexpr bool PERM = false;
    const GAS float* X; GAS float* O; const GAS float* gate;
    __device__ __forceinline__ void operator()(const f32x4 (&acc)[2][2][4][2], const pg8::Unit& u, int wr, int wc, int fr, int fq) const {
        const int b = u.pm >> 4, col0 = u.pn * 256 + wc * 32 + 4 * fq, row0 = u.pm * 256 + wr * 64 + fr;
        f32x4 gv[2][2];
#pragma unroll
        for (int bj = 0; bj < 2; ++bj)
#pragma unroll
            for (int n = 0; n < 2; ++n) gv[bj][n] = *(const GAS f32x4*)(gate + b * 6144 + col0 + bj * 128 + 16 * n);
#pragma unroll
        for (int ai = 0; ai < 2; ++ai)
#pragma unroll
            for (int m = 0; m < 4; ++m) { const size_t ro = (size_t)(row0 + ai * 128 + m * 16) * 1024 + col0;
#pragma unroll
                for (int bj = 0; bj < 2; ++bj)
#pragma unroll
                    for (int n = 0; n < 2; ++n) { const size_t idx = ro + bj * 128 + 16 * n; const f32x4 xv = *(const GAS f32x4*)(X + idx);
                        *(GAS f32x4*)(O + idx) = xv + gv[bj][n] * acc[ai][bj][m][n]; } }
    }
};
struct EpiGU {
    static constexpr bool PERM = true;
    GAS bf16_t* ACT;
    __device__ __forceinline__ void operator()(const f32x4 (&acc)[2][2][4][2], const pg8::Unit& u, int wr, int wc, int fr, int fq) const {
        const __amdgpu_buffer_rsrc_t rA = __builtin_amdgcn_make_buffer_rsrc((void*)ACT, 0, 0x7fffffff, 0x00020000);
        const int col0 = u.pn * 128 + wc * 32 + 8 * fq, row0 = u.pm * 256 + wr * 64 + fr;
#pragma unroll
        for (int ai = 0; ai < 2; ++ai)
#pragma unroll
            for (int m = 0; m < 4; ++m) {
                float r[8];
#pragma unroll
                for (int n = 0; n < 2; ++n)
#pragma unroll
                    for (int e = 0; e < 4; ++e) { const float gt = acc[ai][0][m][n][e], up = acc[ai][1][m][n][e]; r[4 * n + e] = gt * __builtin_amdgcn_rcpf(1.f + __expf(-gt)) * up; }
                u32x4 w; w.x = cvt_pk(r[0], r[1]); w.y = cvt_pk(r[2], r[3]); w.z = cvt_pk(r[4], r[5]); w.w = cvt_pk(r[6], r[7]);
                wt16(rA, ((long)(row0 + ai * 128 + m * 16) * DFF + col0) * 2, w); }
    }
};

template <int MODE> __device__ __forceinline__ int dest_row(int n) {
    if (MODE == 0) { if (n < 1024) return n; if (n < 2560) return 3072 + (n - 1024); if (n < 2576) return -1;
        if (n < 4624) { const int c = n - 2576, base = c < 1024 ? 1024 : 2048, cc = c & 1023, hh = cc >> 6, d = cc & 63;
            return base + 256 * (hh >> 2) + 128 * (d >> 5) + 32 * (hh & 3) + (d & 31); }
        return 4608 + (n - 4624); }
    if (MODE == 1) return n;
    if (MODE == 2) return 256 * (n >> 7) + (n & 127);
    return 256 * (n >> 7) + 128 + (n & 127);
}
template <int MODE> __device__ __forceinline__ void transpose_item(const float* W, int K, int N, bf16_t* WT, LAS float* scr, int item, int lane) {
    const int nblk = (N + 31) / 32, kb = item / nblk, nb = item % nblk, k0 = 64 * kb, n0 = 32 * nb;
    const int nn = n0 + (lane & 31); const bool ok = nn < N;
#pragma unroll
    for (int i = 0; i < 32; ++i) { const int kk = 2 * i + (lane >> 5); scr[kk * 33 + (lane & 31)] = ok ? __builtin_nontemporal_load((const GAS float*)W + (size_t)(k0 + kk) * N + nn) : 0.f; }
    asm volatile("s_waitcnt lgkmcnt(0)" ::: "memory");
    const int c = lane & 7;
#pragma unroll
    for (int j = 0; j < 4; ++j) { const int n = (lane >> 3) + 8 * j; const LAS float* s = scr + (8 * c) * 33 + n;
        const int dr = (n0 + n < N) ? dest_row<MODE>(n0 + n) : -1;
        u32x4 o; o.x = cvt_pk(s[0 * 33], s[1 * 33]); o.y = cvt_pk(s[2 * 33], s[3 * 33]); o.z = cvt_pk(s[4 * 33], s[5 * 33]); o.w = cvt_pk(s[6 * 33], s[7 * 33]);
        if (dr >= 0) *(u32x4*)(WT + (size_t)dr * K + k0 + 8 * c) = o; }
    asm volatile("s_waitcnt lgkmcnt(0)" ::: "memory");
}

__device__ __forceinline__ void chunk_cumsum(float v0, float v1, int lane, float& s0, float& s1) {
    s0 = v0; s1 = v1;
#pragma unroll
    for (int o = 1; o < 64; o <<= 1) { const float t0 = __shfl_up(s0, o), t1 = __shfl_up(s1, o); if (lane >= o) { s0 += t0; s1 += t1; } }
    s1 += __shfl(s0, 63);
}

__global__ void __launch_bounds__(512, 2) fwd(Params p) {
    extern __shared__ __attribute__((aligned(16))) unsigned char lds_raw[];
    LAS unsigned char* lds = (LAS unsigned char*)lds_raw;
    cg::grid_group grid = cg::this_grid();
    const int lo = p.ph_lo, hi = p.ph_hi;
    if (hi > 1000) grid.sync();
    if (threadIdx.x < 2) ((volatile LAS unsigned*)(lds + 131072))[threadIdx.x] = 0u;
    if (threadIdx.x == 0) (void)xb_add((unsigned*)(p.ws + WS_BAR) + XB_XCNT(xb_xcc_id()), 1u);
    __syncthreads();
#define PHASE_VARS \
    int tid = threadIdx.x; asm volatile("" : "+v"(tid)); \
    const int lane = tid & 63, wave = __builtin_amdgcn_readfirstlane(tid >> 6), fr = lane & 15, fq = lane >> 4; \
    int G = gridDim.x; asm volatile("" : "+s"(G)); \
    const int gw = blockIdx.x * 8 + wave, NGW = G * 8; \
    unsigned char* ws = p.ws; asm volatile("" : "+s"(ws)); \
    float* out = p.out; asm volatile("" : "+s"(out)); \
    (void)lane; (void)wave; (void)fr; (void)fq; (void)gw; (void)NGW; (void)ws; (void)out;
#define P_MODP ((float*)(ws + WS_MODP))
#define P_MOD ((float*)(ws + WS_MOD))
#define P_CDEC ((float*)(ws + WS_CDEC))
#define P_WIN ((bf16_t*)(ws + WS_WIN))
#define P_WOUT ((bf16_t*)(ws + WS_WOUT))
#define P_WGU ((bf16_t*)(ws + WS_WGU))
#define P_WDN ((bf16_t*)(ws + WS_WDN))
#define P_DT ((float*)(ws + WS_DT))
#define P_HB ((bf16_t*)(ws + WS_H))
#define P_PROJ ((bf16_t*)(ws + WS_PROJ))
#define P_VT ((bf16_t*)(ws + WS_VT))
#define P_XBC ((bf16_t*)(ws + WS_XBC))
#define P_ST ((bf16_t*)(ws + WS_ST))
#define P_ACT ((bf16_t*)(ws + WS_ACT))
#define P_XC ((bf16_t*)out)
#define P_BC ((bf16_t*)((unsigned char*)out + 32 * MiB))
#define P_BT ((bf16_t*)((unsigned char*)out + 48 * MiB))
#define IN(k) (lo <= (k) && (k) < hi)
#define GRID_BAR() xcd_barrier((unsigned*)(p.ws + WS_BAR), (volatile LAS unsigned*)(lds + 131072))
#define SEAM(k) do { if (IN(k) && IN((k) + 1)) GRID_BAR(); } while (0)

    if (IN(0)) {
        PHASE_VARS
        LAS float* cond = (LAS float*)(lds + 70000 / 16 * 16);
        for (int it = blockIdx.x; it < 192; it += G) {
            const int kc = it / 12, cb = it % 12, j = cb * 512 + tid;
            __syncthreads();
            if (tid < 256) { const int b = tid >> 6, k = kc * 64 + (tid & 63); const float cv = (p.in[1])[b * 1024 + k]; cond[tid] = cv / (1.f + expf(-cv)); }
            __syncthreads();
            float a0 = 0.f, a1 = 0.f, a2 = 0.f, a3 = 0.f;
#pragma unroll 16
            for (int k = 0; k < 64; ++k) { const float w = __builtin_nontemporal_load((const GAS float*)(p.in[2]) + (size_t)(kc * 64 + k) * 6144 + j); a0 += cond[k] * w; a1 += cond[64 + k] * w; a2 += cond[128 + k] * w; a3 += cond[192 + k] * w; }
            P_MODP[(kc * 4 + 0) * 6144 + j] = a0; P_MODP[(kc * 4 + 1) * 6144 + j] = a1; P_MODP[(kc * 4 + 2) * 6144 + j] = a2; P_MODP[(kc * 4 + 3) * 6144 + j] = a3;
        }
        LAS float* scr = (LAS float*)lds + wave * (64 * 33);
        constexpr int I_IN = 16 * 177, I_OUT = 32 * 32, I_G = 16 * 88, I_DN = 44 * 32;
        for (int it = gw; it < I_IN + I_OUT + 2 * I_G + I_DN; it += NGW) {
            int r = it;
            if (r < I_IN) { transpose_item<0>((p.in[5]), 1024, DIN, P_WIN, scr, r, lane); continue; } r -= I_IN;
            if (r < I_OUT) { transpose_item<1>((p.in[14]), 2048, 1024, P_WOUT, scr, r, lane); continue; } r -= I_OUT;
            if (r < I_G) { transpose_item<2>((p.in[16]), 1024, DFF, P_WGU, scr, r, lane); continue; } r -= I_G;
            if (r < I_G) { transpose_item<3>((p.in[17]), 1024, DFF, P_WGU, scr, r, lane); continue; } r -= I_G;
            transpose_item<1>((p.in[18]), DFF, 1024, P_WDN, scr, r, lane);
        }
    }
    SEAM(0);

    if (IN(1)) {
        PHASE_VARS
        LAS float* wdt = (LAS float*)lds; LAS float* scl = wdt + 16384; LAS float* shf = scl + 1024;
        __syncthreads();
        for (int i = tid; i < 16384; i += 512) { const int k = i >> 4, ii = i & 15; wdt[ii * 1024 + k] = ((const GAS float*)(p.in[5]))[(size_t)k * DIN + 2560 + ii]; }
        for (int i = blockIdx.x * 512 + tid; i < 24576; i += G * 512) { float s = (p.in[3])[i % 6144];
#pragma unroll
            for (int kc = 0; kc < 16; ++kc) s += P_MODP[kc * 24576 + i];
            P_MOD[i] = s; }
        for (int rb = blockIdx.x; rb < 256; rb += G) {
            const int b = rb >> 6;
            __syncthreads();
            for (int k = tid; k < 1024; k += 512) { float sh = (p.in[3])[k], sc = (p.in[3])[1024 + k];
#pragma unroll
                for (int kc = 0; kc < 16; ++kc) { sh += P_MODP[(kc * 4 + b) * 6144 + k]; sc += P_MODP[(kc * 4 + b) * 6144 + 1024 + k]; }
                scl[k] = (p.in[4])[k] * (1.f + sc); shf[k] = sh; }
            __syncthreads();
            f32x4 vnx[2][4];
#pragma unroll
            for (int q = 0; q < 2; ++q)
#pragma unroll
                for (int j = 0; j < 4; ++j) vnx[q][j] = __builtin_nontemporal_load((const GAS f32x4*)((const GAS float*)p.in[0] + (size_t)(rb * 64 + wave + 8 * q) * 1024 + 4 * lane + 256 * j));
            for (int r = wave; r < 64; r += 16) {
                const int row0_ = rb * 64 + r;
                f32x4 v[2][4]; float ss[2] = {0.f, 0.f};
#pragma unroll
                for (int q = 0; q < 2; ++q)
#pragma unroll
                    for (int j = 0; j < 4; ++j) { v[q][j] = vnx[q][j];
                        ss[q] += (v[q][j].x * v[q][j].x + v[q][j].y * v[q][j].y) + (v[q][j].z * v[q][j].z + v[q][j].w * v[q][j].w); }
                { const int rn = r + 16 < 64 ? r + 16 : r;
#pragma unroll
                  for (int q = 0; q < 2; ++q)
#pragma unroll
                    for (int j = 0; j < 4; ++j) vnx[q][j] = __builtin_nontemporal_load((const GAS f32x4*)((const GAS float*)p.in[0] + (size_t)(rb * 64 + rn + 8 * q) * 1024 + 4 * lane + 256 * j)); }
                __builtin_amdgcn_sched_barrier(0);
#pragma unroll
                for (int q = 0; q < 2; ++q) {
                    const int row = row0_ + 8 * q;
                    const float rstd = 1.0f / sqrtf(wave_sum(ss[q]) * (1.f / 1024.f) + 1e-6f);
#pragma unroll
                    for (int j = 0; j < 4; ++j) { const int k = 4 * lane + 256 * j; const f32x4 s4 = *(const LAS f32x4*)(scl + k), t4 = *(const LAS f32x4*)(shf + k);
                        v[q][j] = v[q][j] * rstd * s4 + t4;
                        u32x2 w; w.x = cvt_pk(v[q][j].x, v[q][j].y); w.y = cvt_pk(v[q][j].z, v[q][j].w);
                        *(GAS u32x2*)((GAS bf16_t*)P_HB + (size_t)row * 1024 + k) = w; }
                }
                float pa[16], pb[16];
#pragma unroll
                for (int ii = 0; ii < 16; ++ii) { float a0 = 0.f, a1 = 0.f;
#pragma unroll
                    for (int j = 0; j < 4; ++j) { const f32x4 w4 = *(const LAS f32x4*)(wdt + ii * 1024 + 4 * lane + 256 * j);
                        a0 += (v[0][j].x * w4.x + v[0][j].y * w4.y) + (v[0][j].z * w4.z + v[0][j].w * w4.w);
                        a1 += (v[1][j].x * w4.x + v[1][j].y * w4.y) + (v[1][j].z * w4.z + v[1][j].w * w4.w); }
                    pa[ii] = a0; pb[ii] = a1; }
                const int oi = ((lane >> 5) & 1) * 8 + ((lane >> 4) & 1) * 4 + ((lane >> 3) & 1) * 2 + ((lane >> 2) & 1);
                const float dtb = (p.in[8])[oi];
#pragma unroll
                for (int st = 0; st < 4; ++st) { const int msk = 32 >> st, cnt = 8 >> st; const bool up = (lane & msk) != 0;
#pragma unroll
                    for (int i = 0; i < 8; ++i) if (i < cnt) {
                        { const float keep = up ? pa[i + cnt] : pa[i], send = up ? pa[i] : pa[i + cnt]; pa[i] = keep + __shfl_xor(send, msk); }
                        { const float keep = up ? pb[i + cnt] : pb[i], send = up ? pb[i] : pb[i + cnt]; pb[i] = keep + __shfl_xor(send, msk); } } }
                float t0 = pa[0], t1 = pb[0]; t0 += __shfl_xor(t0, 2); t1 += __shfl_xor(t1, 2); t0 += __shfl_xor(t0, 1); t1 += __shfl_xor(t1, 1);
                if ((lane & 3) == 0) { const float z0 = t0 + dtb, z1 = t1 + dtb;
                    P_DT[(size_t)row0_ * 16 + oi] = z0 > 20.f ? z0 : log1pf(expf(z0)); P_DT[(size_t)(row0_ + 8) * 16 + oi] = z1 > 20.f ? z1 : log1pf(expf(z1)); }
            }
        }
    }
    SEAM(1);

    if (IN(2)) {
        PHASE_VARS
        __syncthreads();
        { pg8::Gemm g{P_HB, P_WIN, MT, 4608, 1024, 1024}; pg8::StaticOrder S; S.init(MT, 4608, G, (int)blockIdx.x); EpiProj E{(GAS bf16_t*)P_PROJ, (GAS bf16_t*)P_XBC, (const GAS float*)p.in[12], (const GAS float*)p.in[13], (GAS bf16_t*)out};
          pg8::gemm_phase<EpiProj, true>(lds, g, S, E); }
        { pg8::Gemm g{P_WIN + (size_t)4608 * 1024, P_HB, 1024, MT, 1024, 1024}; pg8::StaticOrder S; S.init(1024, MT, G, (int)blockIdx.x); EpiVT E{(GAS bf16_t*)P_VT};
          pg8::gemm_phase<EpiVT, true>(lds, g, S, E); }
    }
    SEAM(2);

    if (IN(3)) {
        PHASE_VARS
        __syncthreads();
        LAS bf16_t* tile = (LAS bf16_t*)lds + wave * (64 * 72);
        for (int un = blockIdx.x; un < 256; un += G)
        for (int j = wave; j < 24; j += 8) {
            const int b = un >> 6, c_ = (un >> 1) & 31, g_ = un & 1, tbl = j / 12, cl = j % 12;
            const int cb = cl < 8 ? 8 * g_ + cl : (cl < 10 ? 16 + 2 * g_ + (cl - 8) : 20 + 2 * g_ + (cl - 10)), tb = 2 * c_ + tbl;
            const int ch = cb * 64 + lane;
            const float w0 = (p.in[6])[ch], w1 = (p.in[6])[1536 + ch], w2 = (p.in[6])[3072 + ch], w3 = (p.in[6])[4608 + ch], bs = (p.in[7])[ch];
            const bf16_t* src = P_XBC + ((size_t)b * 4096 + tb * 64) * 1536 + ch;
            const GAS bf16_t* srcg = (const GAS bf16_t*)src;
            float u0 = 0.f, u1 = 0.f, u2 = 0.f;
            if (tb > 0) { u0 = bf2f(srcg[-3 * 1536]); u1 = bf2f(srcg[-2 * 1536]); u2 = bf2f(srcg[-1536]); }
            bf16_t raw[64];
#pragma unroll
            for (int t = 0; t < 64; ++t) raw[t] = srcg[(size_t)t * 1536];
            bf16_t* dstn; int ldn;
            if (cb < 16) { dstn = P_XC + ((size_t)b * 4096 + tb * 64) * 1024 + ch; ldn = 1024; } else { dstn = P_BC + ((size_t)b * 4096 + tb * 64) * 512 + (ch - 1024); ldn = 512; }
            GAS bf16_t* dstg = (GAS bf16_t*)dstn;
            bf16_t ybp = 0;
#pragma unroll
            for (int t = 0; t < 64; ++t) {
                const float u3 = bf2f(raw[t]);
                const float v = bs + w0 * u0 + w1 * u1 + w2 * u2 + w3 * u3;
                const float y = v * __builtin_amdgcn_rcpf(1.f + __expf(-v));
                const bf16_t yb = (bf16_t)f2bf(y);
                if (cb >= 16) dstg[(size_t)t * ldn] = yb;
                if (t & 1) ((LAS unsigned*)tile)[lane * 34 + (t >> 1)] = (unsigned)ybp | ((unsigned)yb << 16); else ybp = yb;
                u0 = u1; u1 = u2; u2 = u3;
            }
            asm volatile("s_waitcnt lgkmcnt(0)" ::: "memory");
            if (cb < 20) {
#pragma unroll
                for (int i = 0; i < 8; ++i) { const int r = i * 8 + (lane >> 3), cc = lane & 7;
                    const u32x2 va = *(const LAS u32x2*)(tile + r * 68 + cc * 8), vb = *(const LAS u32x2*)(tile + r * 68 + cc * 8 + 4);
                    u32x4 val; val.x = va.x; val.y = va.y; val.z = vb.x; val.w = vb.y;
                    bf16_t* dp;
                    if (cb < 16) dp = P_HB + (((((size_t)(b * 16 + cb) * 128 + tb * 2 + (cc >> 2)) * 4 + (r >> 4)) * 64) + (cc & 3) * 16 + (r & 15)) * 8;
                    else { const int ng = (cb - 16) * 64 + r, nn = ng & 127; dp = P_BT + (((((size_t)(b * 2 + (ng >> 7)) * 128 + tb * 2 + (cc >> 2)) * 8 + (nn >> 4)) * 64) + (cc & 3) * 16 + (nn & 15)) * 8; }
                    *(u32x4*)dp = val; }
            }
            asm volatile("s_waitcnt lgkmcnt(0)" ::: "memory");
        }
    }

    if (IN(4)) {
        PHASE_VARS
        for (int un = blockIdx.x; un < 256; un += G) {
            const int b = un >> 6, c = (un >> 1) & 31, g = un & 1, h = g * 8 + wave;
            LAS float* wl = (LAS float*)lds + wave * 128;
            asm volatile("s_waitcnt vmcnt(0)" ::: "memory");
            __syncthreads();
            const float ah = -expf((p.in[9])[h]);
            const size_t tok0 = (size_t)b * 4096 + c * 128;
            const float dt0 = ((const GAS float*)P_DT)[(tok0 + lane) * 16 + h], dt1 = ((const GAS float*)P_DT)[(tok0 + 64 + lane) * 16 + h];
            float s0, s1; chunk_cumsum(ah * dt0, ah * dt1, lane, s0, s1);
            const float last = __shfl(s1, 63);
            wl[lane] = expf(last - s0) * dt0; wl[64 + lane] = expf(last - s1) * dt1;
            if (lane == 0) P_CDEC[(b * 32 + c) * 16 + h] = expf(last);
            __syncthreads();
            f32x4 acc[4][8];
#pragma unroll
            for (int mi = 0; mi < 4; ++mi)
#pragma unroll
                for (int ni = 0; ni < 8; ++ni) acc[mi][ni] = (f32x4){0.f, 0.f, 0.f, 0.f};
            const GAS bf16_t* xt = (const GAS bf16_t*)P_HB + (((size_t)(b * 16 + h) * 128 + c * 4) * 4) * 512 + lane * 8;
            const GAS bf16_t* bt = (const GAS bf16_t*)P_BT + (((size_t)(b * 2 + g) * 128 + c * 4) * 8) * 512 + lane * 8;
#pragma unroll 2
            for (int ks = 0; ks < 4; ++ks) {
                const f32x4 wa = *(const LAS f32x4*)(wl + 32 * ks + 8 * fq), wb = *(const LAS f32x4*)(wl + 32 * ks + 8 * fq + 4);
                bf16x8 xf[4];
#pragma unroll
                for (int mi = 0; mi < 4; ++mi) { const u32x4 raw = *(const GAS u32x4*)(xt + (ks * 4 + mi) * 512); u32x4 o;
                    o.x = cvt_pk(bflo(raw.x) * wa.x, bfhi(raw.x) * wa.y); o.y = cvt_pk(bflo(raw.y) * wa.z, bfhi(raw.y) * wa.w);
                    o.z = cvt_pk(bflo(raw.z) * wb.x, bfhi(raw.z) * wb.y); o.w = cvt_pk(bflo(raw.w) * wb.z, bfhi(raw.w) * wb.w);
                    xf[mi] = __builtin_bit_cast(bf16x8, o); }
#pragma unroll
                for (int ni = 0; ni < 8; ++ni) { const bf16x8 bf = *(const GAS bf16x8*)(bt + (ks * 8 + ni) * 512);
#pragma unroll
                    for (int mi = 0; mi < 4; ++mi) acc[mi][ni] = MFMA16(bf, xf[mi], acc[mi][ni]); }
            }
            GAS bf16_t* st = (GAS bf16_t*)P_ST + ((size_t)((b * 32 + c) * 16 + h) * 64) * 128;
#pragma unroll
            for (int mi = 0; mi < 4; ++mi)
#pragma unroll
                for (int ni = 0; ni < 8; ++ni) { u32x2 w; w.x = cvt_pk(acc[mi][ni][0], acc[mi][ni][1]); w.y = cvt_pk(acc[mi][ni][2], acc[mi][ni][3]);
                    *(GAS u32x2*)(st + ((mi * 4 + (ni >> 1)) * 64 + (2 * (ni & 1) + (fq >> 1)) * 16 + fr) * 8 + 4 * (fq & 1)) = w; }
        }
    }
    SEAM(4);

    if (IN(5)) {
        PHASE_VARS
        unsigned* ST32 = (unsigned*)P_ST;
        for (int gid = blockIdx.x * 512 + tid; gid < 262144; gid += G * 512) {
            const int b = gid >> 16, rem = gid & 65535, h = rem >> 12, pn = rem & 4095;
            const GAS unsigned* sg = (const GAS unsigned*)ST32 + ((size_t)(b * 32 * 16 + h)) * 4096 + pn;
            const GAS float* dg = (const GAS float*)P_CDEC + b * 32 * 16 + h;
            unsigned vv[32]; float dd[32];
#pragma unroll
            for (int c = 0; c < 32; ++c) { vv[c] = sg[(size_t)c * 16 * 4096]; dd[c] = dg[c * 16]; }
            float r0 = 0.f, r1 = 0.f;
#pragma unroll
            for (int c = 0; c < 32; ++c) {
                ((GAS unsigned*)sg)[(size_t)c * 16 * 4096] = cvt_pk(r0, r1);
                r0 = r0 * dd[c] + bflo(vv[c]); r1 = r1 * dd[c] + bfhi(vv[c]);
            }
        }
    }
    SEAM(5);

    if (IN(6)) {
        PHASE_VARS
#ifndef SKIP_S3
        for (int un = blockIdx.x; un < 256; un += G) {
            const int b = un >> 6, c = (un >> 1) & 31, g = un & 1, h = g * 8 + wave;
            LAS float* SC = (LAS float*)lds;
            LAS float* acsl = SC + 128 * 132 + wave * 256;
            LAS float* ssqp = SC + 128 * 132 + 8 * 256;
            const size_t tok0 = (size_t)b * 4096 + c * 128;
            __syncthreads();
            {
                f32x4 sacc[8];
#pragma unroll
                for (int ni = 0; ni < 8; ++ni) sacc[ni] = (f32x4){0.f, 0.f, 0.f, 0.f};
                const GAS bf16_t* cp = (const GAS bf16_t*)P_BC + (tok0 + 16 * wave + fr) * 512 + 256 + g * 128 + 8 * fq;
                const GAS bf16_t* bp = (const GAS bf16_t*)P_BC + (tok0 + fr) * 512 + g * 128 + 8 * fq;
#pragma unroll 2
                for (int ks = 0; ks < 4; ++ks) { const bf16x8 cf = *(const GAS bf16x8*)(cp + 32 * ks);
#pragma unroll
                    for (int ni = 0; ni < 8; ++ni) if (ni <= wave) { const bf16x8 bf = *(const GAS bf16x8*)(bp + (size_t)ni * 16 * 512 + 32 * ks); sacc[ni] = MFMA16(cf, bf, sacc[ni]); } }
#pragma unroll
                for (int ni = 0; ni < 8; ++ni) if (ni <= wave) {
#pragma unroll
                    for (int r = 0; r < 4; ++r) SC[(16 * wave + 4 * fq + r) * 132 + 16 * ni + fr] = sacc[ni][r]; }
            }
            const float ah = -expf((p.in[9])[h]);
            {
                const float dt0 = ((const GAS float*)P_DT)[(tok0 + lane) * 16 + h], dt1 = ((const GAS float*)P_DT)[(tok0 + 64 + lane) * 16 + h];
                float s0, s1; chunk_cumsum(ah * dt0, ah * dt1, lane, s0, s1);
                acsl[lane] = s0; acsl[64 + lane] = s1; acsl[128 + lane] = dt0; acsl[192 + lane] = dt1;
            }
            __syncthreads();
            f32x4 acc[8][4];
#pragma unroll
            for (int mi = 0; mi < 8; ++mi)
#pragma unroll
                for (int ni = 0; ni < 4; ++ni) acc[mi][ni] = (f32x4){0.f, 0.f, 0.f, 0.f};
            {
                const GAS bf16_t* pv = (const GAS bf16_t*)P_ST + ((size_t)((b * 32 + c) * 16 + h) * 64) * 128 + lane * 8;
                const GAS bf16_t* cq = (const GAS bf16_t*)P_BC + (tok0 + fr) * 512 + 256 + g * 128 + 8 * fq;
#pragma unroll 2
                for (int ks = 0; ks < 4; ++ks) { bf16x8 pf[4];
#pragma unroll
                    for (int ni = 0; ni < 4; ++ni) pf[ni] = *(const GAS bf16x8*)(pv + (ni * 4 + ks) * 512);
#pragma unroll
                    for (int mi = 0; mi < 8; ++mi) { const bf16x8 cf = *(const GAS bf16x8*)(cq + (size_t)mi * 16 * 512 + 32 * ks);
#pragma unroll
                        for (int ni = 0; ni < 4; ++ni) acc[mi][ni] = MFMA16(pf[ni], cf, acc[mi][ni]); } }
#pragma unroll
                for (int mi = 0; mi < 8; ++mi) { const float e = __expf(acsl[16 * mi + fr]);
#pragma unroll
                    for (int ni = 0; ni < 4; ++ni) acc[mi][ni] = acc[mi][ni] * e; }
            }
            const float Dh = (p.in[10])[h];
            {
                const GAS bf16_t* xt = (const GAS bf16_t*)P_HB + (((size_t)(b * 16 + h) * 128 + c * 4) * 4) * 512 + lane * 8;
#pragma unroll 1
                for (int ks = 0; ks < 4; ++ks) { bf16x8 xf[4];
#pragma unroll
                    for (int ni = 0; ni < 4; ++ni) xf[ni] = *(const GAS bf16x8*)(xt + (ks * 4 + ni) * 512);
                    float as_[8], ds_[8];
#pragma unroll
                    for (int i = 0; i < 8; ++i) { as_[i] = acsl[32 * ks + 8 * fq + i]; ds_[i] = acsl[128 + 32 * ks + 8 * fq + i]; }
#pragma unroll
                    for (int mi = 0; mi < 8; ++mi) if (16 * mi + 15 >= 32 * ks) {
                        const int l = 16 * mi + fr; const float al = acsl[l];
                        const f32x4 g0 = *(const LAS f32x4*)(SC + l * 132 + 32 * ks + 8 * fq), g1 = *(const LAS f32x4*)(SC + l * 132 + 32 * ks + 8 * fq + 4);
                        float gv[8];
#pragma unroll
                        for (int i = 0; i < 8; ++i) { const int s = 32 * ks + 8 * fq + i; const float sc = i < 4 ? g0[i & 3] : g1[i & 3];
                            const float val = sc * __expf(al - as_[i]) * ds_[i]; gv[i] = (s <= l) ? val : 0.f; if (s == l) gv[i] += Dh; }
                        u32x4 o; o.x = cvt_pk(gv[0], gv[1]); o.y = cvt_pk(gv[2], gv[3]); o.z = cvt_pk(gv[4], gv[5]); o.w = cvt_pk(gv[6], gv[7]);
                        const bf16x8 gf = __builtin_bit_cast(bf16x8, o);
#pragma unroll
                        for (int ni = 0; ni < 4; ++ni) acc[mi][ni] = MFMA16(xf[ni], gf, acc[mi][ni]); }
                }
            }
            {
#pragma unroll
                for (int mi = 0; mi < 8; ++mi) { const int l = 16 * mi + fr; const size_t tok = tok0 + l; float s = 0.f;
#pragma unroll
                    for (int ni = 0; ni < 4; ++ni) { const int ch = h * 64 + 16 * ni + 4 * fq;
                        const u32x2 zz = *(const GAS u32x2*)((const GAS bf16_t*)P_PROJ + tok * 3072 + ch);
                        const float zv[4] = {bflo(zz.x), bfhi(zz.x), bflo(zz.y), bfhi(zz.y)};
#pragma unroll
                        for (int e = 0; e < 4; ++e) { float y = acc[mi][ni][e]; y *= zv[e] * __builtin_amdgcn_rcpf(1.f + __expf(-zv[e])); acc[mi][ni][e] = y; s += y * y; } }
                    s += __shfl_xor(s, 16); s += __shfl_xor(s, 32);
                    if (fq == 0) ssqp[wave * 128 + l] = s; }
                __syncthreads();
#pragma unroll
                for (int mi = 0; mi < 8; ++mi) { const int l = 16 * mi + fr; const size_t tok = tok0 + l; float tot = 0.f;
#pragma unroll
                    for (int w = 0; w < 8; ++w) tot += ssqp[w * 128 + l];
                    const float rstd = 1.0f / sqrtf(tot * (1.f / 512.f) + 1e-6f);
#pragma unroll
                    for (int ni = 0; ni < 4; ++ni) { const int ch = h * 64 + 16 * ni + 4 * fq; const f32x4 nw4 = *(const GAS f32x4*)((const GAS float*)(p.in[11]) + ch);
                        u32x2 w; w.x = cvt_pk(acc[mi][ni][0] * rstd * nw4.x, acc[mi][ni][1] * rstd * nw4.y); w.y = cvt_pk(acc[mi][ni][2] * rstd * nw4.z, acc[mi][ni][3] * rstd * nw4.w);
                        *(GAS u32x2*)((GAS bf16_t*)P_PROJ + tok * 3072 + ch) = w; } }
            }
        }
#endif
#ifndef SKIP_ATT
        for (int it = 0;; ++it) {
            int qt, bh;
            if ((G & 7) == 0) {
                int uidx = 0;
                if (lane == 0) uidx = (int)__hip_atomic_fetch_add((unsigned*)(p.ws + WS_BAR) + 3520 + 64 * (blockIdx.x & 7), 1u, __ATOMIC_RELAXED, __HIP_MEMORY_SCOPE_AGENT);
                uidx = __builtin_amdgcn_readfirstlane(uidx);
                if (uidx >= 1024) break; qt = uidx & 127; bh = (blockIdx.x & 7) + 8 * (uidx >> 7); }
            else { const int wu = gw + it * NGW; if (wu >= 8192) break; qt = wu & 127; bh = wu >> 7; }
            const int b = bh >> 4, h = bh & 15, q0 = qt * 32;
            bf16_t* qp = P_PROJ + ((size_t)b * 4096 + q0 + fr) * 3072 + 1024 + h * 64;
            const GAS bf16_t* qg = (const GAS bf16_t*)qp;
            bf16x8 qf[2][2];
#pragma unroll
            for (int t = 0; t < 2; ++t) { qf[t][0] = *(const GAS bf16x8*)(qg + (size_t)t * 16 * 3072 + 8 * fq); qf[t][1] = *(const GAS bf16x8*)(qg + (size_t)t * 16 * 3072 + 32 + 8 * fq); }
            f32x4 o[2][4];
#pragma unroll
            for (int t = 0; t < 2; ++t)
#pragma unroll
                for (int di = 0; di < 4; ++di) o[t][di] = (f32x4){0.f, 0.f, 0.f, 0.f};
            float carry[2] = {0.f, 0.f};
            const GAS bf16_t* kbase = (const GAS bf16_t*)out + (size_t)bh * (256 * 1024) + lane * 8;
            const GAS bf16_t* vbase = (const GAS bf16_t*)P_VT + (size_t)bh * (128 * 2048) + lane * 8;
            int kb = (q0 + 30) >> 6;
            bf16x8 kc[8];
#pragma unroll
            for (int ki = 0; ki < 4; ++ki) { const GAS bf16_t* kp = kbase + (size_t)(kb * 4 + ki) * 1024; kc[2 * ki] = *(const GAS bf16x8*)kp; kc[2 * ki + 1] = *(const GAS bf16x8*)(kp + 512); }
            for (;;) {
                const int j0 = kb * 64;
                bf16x8 vv[8];
#pragma unroll
                for (int kk = 0; kk < 2; ++kk)
#pragma unroll
                    for (int di = 0; di < 4; ++di) vv[kk * 4 + di] = *(const GAS bf16x8*)(vbase + (size_t)(((j0 >> 5) + kk) * 4 + di) * 512);
                bf16x8 kn[8];
                { const int jn = (kb > 0 ? kb - 1 : 0) * 64;
#pragma unroll
                  for (int ki = 0; ki < 4; ++ki) { const GAS bf16_t* kp = kbase + (size_t)((jn >> 4) + ki) * 1024; kn[2 * ki] = *(const GAS bf16x8*)kp; kn[2 * ki + 1] = *(const GAS bf16x8*)(kp + 512); } }
                const bool diag = j0 + 63 >= q0;
#pragma unroll
                for (int t = 0; t < 2; ++t) {
                    const int qlim = diag ? q0 + 16 * t + fr : 0x7fffffff;
                    f32x4 s[4];
#pragma unroll
                    for (int ki = 0; ki < 4; ++ki) { s[ki] = MFMA16(kc[2 * ki], qf[t][0], ((f32x4){0.f, 0.f, 0.f, 0.f})); s[ki] = MFMA16(kc[2 * ki + 1], qf[t][1], s[ki]); }
                    float sp[4][4], lw[4][4], gs[4], rowtot[4], above[4];
#pragma unroll
                    for (int ki = 0; ki < 4; ++ki) {
#pragma unroll
                        for (int r = 0; r < 4; ++r) { const float l = s[ki][r];
                            const float spv = fmaxf(l, 0.f) + __builtin_amdgcn_logf(1.f + __builtin_amdgcn_exp2f(-fabsf(l)));
                            const int key = j0 + 16 * ki + 4 * fq + r;
                            sp[ki][r] = key < qlim ? spv : 0.f; lw[ki][r] = l - spv; }
                        gs[ki] = (sp[ki][0] + sp[ki][1]) + (sp[ki][2] + sp[ki][3]);
                        const float g16 = __shfl_xor(gs[ki], 16), g32 = __shfl_xor(gs[ki], 32), g48 = __shfl_xor(gs[ki], 48);
                        rowtot[ki] = (gs[ki] + g16) + (g32 + g48);
                        above[ki] = ((fq ^ 1) > fq ? g16 : 0.f) + ((fq ^ 2) > fq ? g32 : 0.f) + ((fq ^ 3) > fq ? g48 : 0.f);
                    }
                    float run = carry[t]; float wv[4][4];
#pragma unroll
                    for (int ki = 3; ki >= 0; --ki) { const float r3 = run + above[ki], r2 = r3 + sp[ki][3], r1 = r2 + sp[ki][2], r0 = r1 + sp[ki][1];
                        const int key0 = j0 + 16 * ki + 4 * fq;
                        wv[ki][3] = key0 + 3 < qlim ? __builtin_amdgcn_exp2f(lw[ki][3] - r3) : 0.f; wv[ki][2] = key0 + 2 < qlim ? __builtin_amdgcn_exp2f(lw[ki][2] - r2) : 0.f;
                        wv[ki][1] = key0 + 1 < qlim ? __builtin_amdgcn_exp2f(lw[ki][1] - r1) : 0.f; wv[ki][0] = key0 < qlim ? __builtin_amdgcn_exp2f(lw[ki][0] - r0) : 0.f;
                        run += rowtot[ki]; }
                    carry[t] = run;
#pragma unroll
                    for (int kk = 0; kk < 2; ++kk) { u32x4 pw; pw.x = cvt_pk(wv[2 * kk][0], wv[2 * kk][1]); pw.y = cvt_pk(wv[2 * kk][2], wv[2 * kk][3]);
                        pw.z = cvt_pk(wv[2 * kk + 1][0], wv[2 * kk + 1][1]); pw.w = cvt_pk(wv[2 * kk + 1][2], wv[2 * kk + 1][3]);
                        const bf16x8 pf = __builtin_bit_cast(bf16x8, pw);
#pragma unroll
                        for (int di = 0; di < 4; ++di) o[t][di] = MFMA16(vv[kk * 4 + di], pf, o[t][di]); }
                }
                if (kb == 0 || __all(fminf(carry[0], carry[1]) > 57.71f)) break;
                --kb;
#pragma unroll
                for (int i = 0; i < 8; ++i) kc[i] = kn[i];
            }
#pragma unroll
            for (int t = 0; t < 2; ++t)
#pragma unroll
                for (int di = 0; di < 4; ++di) { u32x2 w; w.x = cvt_pk(o[t][di][0], o[t][di][1]); w.y = cvt_pk(o[t][di][2], o[t][di][3]);
                    *(GAS u32x2*)((GAS bf16_t*)qp + (size_t)t * 16 * 3072 + 16 * di + 4 * fq) = w; }
        }
#endif
    }
    SEAM(6);

    if (IN(7)) {
        PHASE_VARS
        __syncthreads();
        pg8::Gemm g{P_PROJ, P_WOUT, MT, 1024, 2048, 3072}; pg8::StaticOrder S; S.init(MT, 1024, G, (int)blockIdx.x); EpiRes E{(const GAS float*)p.in[0], (GAS float*)out, (const GAS float*)(P_MOD + 2048)};
        pg8::gemm_phase<EpiRes, true>(lds, g, S, E);
    }
    SEAM(7);

    if (IN(8)) {
        PHASE_VARS
        for (int row0_ = gw; row0_ < MT; row0_ += 2 * NGW) {
            f32x4 v[2][4]; float ss[2] = {0.f, 0.f};
#pragma unroll
            for (int q = 0; q < 2; ++q)
#pragma unroll
                for (int j = 0; j < 4; ++j) { const int row = row0_ + q * NGW < MT ? row0_ + q * NGW : row0_;
                    v[q][j] = *(const GAS f32x4*)((const GAS float*)out + (size_t)row * 1024 + 4 * lane + 256 * j);
                    ss[q] += (v[q][j].x * v[q][j].x + v[q][j].y * v[q][j].y) + (v[q][j].z * v[q][j].z + v[q][j].w * v[q][j].w); }
#pragma unroll
            for (int q = 0; q < 2; ++q) { const int row = row0_ + q * NGW; if (row < MT) {
                const int b = row >> 12;
                const float rstd = 1.0f / sqrtf(wave_sum(ss[q]) * (1.f / 1024.f) + 1e-6f);
#pragma unroll
                for (int j = 0; j < 4; ++j) { const int k = 4 * lane + 256 * j;
                    const f32x4 nw = *(const f32x4*)((p.in[15]) + k), sc = *(const f32x4*)(P_MOD + b * 6144 + 4096 + k), sh = *(const f32x4*)(P_MOD + b * 6144 + 3072 + k);
                    const f32x4 hv = v[q][j] * rstd * nw * (sc + 1.f) + sh;
                    u32x2 w; w.x = cvt_pk(hv.x, hv.y); w.y = cvt_pk(hv.z, hv.w);
                    *(GAS u32x2*)((GAS bf16_t*)P_HB + (size_t)row * 1024 + k) = w; } } }
        }
    }
    SEAM(8);

    if (IN(9)) {
        PHASE_VARS
        __syncthreads();
        pg8::Gemm g{P_HB, P_WGU, MT, 5632, 1024, 1024}; pg8::StaticOrder S; S.init(MT, 5632, G, (int)blockIdx.x); EpiGU E{(GAS bf16_t*)P_ACT};
        pg8::gemm_phase<EpiGU, true>(lds, g, S, E);
    }
    SEAM(9);

    if (IN(10)) {
        PHASE_VARS
        __syncthreads();
        pg8::Gemm g{P_ACT, P_WDN, MT, 1024, DFF, DFF}; pg8::StaticOrder S; S.init(MT, 1024, G, (int)blockIdx.x); EpiRes E{(const GAS float*)out, (GAS float*)out, (const GAS float*)(P_MOD + 5120)};
        pg8::gemm_phase<EpiRes, true>(lds, g, S, E);
    }

#ifdef DBG_HI
    GRID_BAR();
    {   PHASE_VARS
        for (size_t i = (size_t)blockIdx.x * 512 + tid; i < (size_t)MT * 1024; i += (size_t)G * 512) {
            const size_t m = i >> 10, c = i & 1023;
            out[i] = DBG_EXPR;
        }
    }
#endif
#undef IN
#undef SEAM
}

extern "C" void kernel_launch(void* const* d_in, const int* in_sizes, int n_in, void* d_out, int out_size, void* d_ws, size_t ws_size, hipStream_t stream) {
    static int grid = 0;
    if (grid == 0) {
        if (n_in != 19 || out_size != MT * DM || ws_size < WS_END) { fprintf(stderr, "kernel_launch: unexpected shapes (n_in %d out %d ws %zu)\n", n_in, out_size, ws_size); grid = -1; return; }
        int dev = 0, cus = 0, per_cu = 0;
        hipGetDevice(&dev);
        hipDeviceGetAttribute(&cus, hipDeviceAttributeMultiprocessorCount, dev);
        hipFuncSetAttribute((const void*)fwd, hipFuncAttributeMaxDynamicSharedMemorySize, LDS_BYTES);
        hipOccupancyMaxActiveBlocksPerMultiprocessor(&per_cu, (const void*)fwd, 512, LDS_BYTES);
        if (per_cu < 1) { fprintf(stderr, "kernel_launch: occupancy query says %d blocks/CU\n", per_cu); per_cu = 1; }
        grid = cus * per_cu;
    }
    if (grid < 0) return;
    if (hipMemsetAsync((char*)d_ws + WS_BAR, 0, 16384, stream) != hipSuccess) { fprintf(stderr, "kernel_launch: memset failed\n"); return; }
    Params p{};
    for (int i = 0; i < 19; ++i) p.in[i] = (const float*)d_in[i];
    p.out = (float*)d_out; p.ws = (unsigned char*)d_ws; p.ph_lo = 0;
#ifdef DBG_HI
    p.ph_hi = DBG_HI;
#else
    p.ph_hi = 11;
#endif
    void* args[] = {&p};
    hipError_t e = hipLaunchCooperativeKernel((const void*)fwd, dim3(grid), dim3(512), args, LDS_BYTES, stream);
    if (e != hipSuccess) fprintf(stderr, "cooperative launch failed: %s (grid %d)\n", hipGetErrorString(e), grid);
}
```
